# Optimizing an MI355X kernel written in HIP

```python
import jax, jax.numpy as jnp
from jax import lax
import numpy as np

D_MODEL = 1024
BATCH = 8
SEQ = 4096
DEPTH = 4

N_MIXERS = 2
HEAD_DIM = 64
FOX_HEADS = D_MODEL // HEAD_DIM
DIL_HEADS = D_MODEL // HEAD_DIM
DIL_CONFIGS = ((128, 1), (512, 4), (2048, 16))
N_DIL_GROUPS = len(DIL_CONFIGS)
ROPE_THETA = 500000.0
ROPE_DIM = HEAD_DIM // 4
D_FF = 2816
Q_BLOCK = 128
EPS = 1e-6
MACARON_WEIGHT = 0.5
N_SUBLAYERS = 3
N_FOX_LAYERS = (DEPTH + 1) // 2
N_DIL_LAYERS = DEPTH // 2
FOX_IN = 3 * FOX_HEADS * HEAD_DIM + FOX_HEADS
DIL_IN = N_DIL_GROUPS * 3 * DIL_HEADS * HEAD_DIM

kernel_name = "hybrid_fox_dilated_macaron_adaln"


def rms_norm(x, g):
    xf = x.astype(jnp.float32)
    y = xf * lax.rsqrt(jnp.mean(xf * xf, axis=-1, keepdims=True) + EPS)
    return (y * g.astype(jnp.float32)).astype(x.dtype)


def modulate(h, shift, scale):
    return h * (1.0 + scale[:, None, :]) + shift[:, None, :]


def swiglu(h, w_gate, w_up, w_down):
    return (jax.nn.silu(h @ w_gate) * (h @ w_up)) @ w_down


def rope_tables(positions):
    half = ROPE_DIM // 2
    inv_freq = ROPE_THETA ** (-(jnp.arange(half, dtype=jnp.float32) * 2.0 / ROPE_DIM))
    ang = positions.astype(jnp.float32)[..., None] * inv_freq
    return jnp.cos(ang)[:, :, None, :], jnp.sin(ang)[:, :, None, :]


def apply_rope(x, cos, sin):
    half = ROPE_DIM // 2
    xr = x[..., :ROPE_DIM].astype(jnp.float32)
    x1, x2 = xr[..., :half], xr[..., half:]
    rot = jnp.concatenate([x1 * cos - x2 * sin, x2 * cos + x1 * sin], axis=-1).astype(x.dtype)
    return jnp.concatenate([rot, x[..., ROPE_DIM:]], axis=-1)


def fox_attention(h, w_in, b_f, q_gain, k_gain, w_out):
    B, S, _ = h.shape
    H, hd = FOX_HEADS, HEAD_DIM
    proj = h @ w_in
    qkv = proj[..., : 3 * H * hd].reshape(B, S, 3, H, hd)
    f_logit = proj[..., 3 * H * hd:].astype(jnp.float32) + b_f.astype(jnp.float32)
    q = rms_norm(qkv[:, :, 0], q_gain).transpose(0, 2, 1, 3)
    k = rms_norm(qkv[:, :, 1], k_gain).transpose(0, 2, 1, 3)
    v = qkv[:, :, 2].transpose(0, 2, 1, 3)
    cum = jnp.cumsum(jax.nn.log_sigmoid(f_logit), axis=1).transpose(0, 2, 1)
    scale = hd ** -0.5
    outs = []
    for blk in range(S // Q_BLOCK):
        q0 = blk * Q_BLOCK
        kv_len = q0 + Q_BLOCK
        logits = jnp.einsum("bhqd,bhkd->bhqk", q[:, :, q0:kv_len], k[:, :, :kv_len]).astype(jnp.float32) * scale
        logits = logits + cum[:, :, q0:kv_len, None] - cum[:, :, None, :kv_len]
        q_idx = q0 + jnp.arange(Q_BLOCK)
        k_idx = jnp.arange(kv_len)
        mask = k_idx[None, :] <= q_idx[:, None]
        logits = jnp.where(mask[None, None], logits, -jnp.inf)
        p = jax.nn.softmax(logits, axis=-1).astype(v.dtype)
        outs.append(jnp.einsum("bhqk,bhkd->bhqd", p, v[:, :, :kv_len]))
    o = jnp.concatenate(outs, axis=2).transpose(0, 2, 1, 3).reshape(B, S, H * hd)
    return o @ w_out


def dilated_group(q, k, v, window, dilation):
    B, S, H, hd = q.shape
    n_keys = window // dilation + 1
    offsets = dilation * jnp.arange(n_keys)
    scale = hd ** -0.5

    def block_fn(q0):
        qb = lax.dynamic_slice_in_dim(q, q0, Q_BLOCK, axis=1)
        t = q0 + jnp.arange(Q_BLOCK)
        idx = t[:, None] - offsets[None, :]
        valid = idx >= 0
        idx_c = jnp.maximum(idx, 0)
        kb = jnp.take(k, idx_c, axis=1)
        vb = jnp.take(v, idx_c, axis=1)
        logits = jnp.einsum("bqhd,bqkhd->bhqk", qb, kb).astype(jnp.float32) * scale
        logits = jnp.where(valid[None, None], logits, -jnp.inf)
        lse = jax.nn.logsumexp(logits, axis=-1)
        p = jnp.exp(logits - lse[..., None]).astype(v.dtype)
        ob = jnp.einsum("bhqk,bqkhd->bqhd", p, vb)
        return ob, lse

    starts = jnp.arange(S // Q_BLOCK) * Q_BLOCK
    o, lse = lax.map(block_fn, starts)
    o = o.transpose(1, 0, 2, 3, 4).reshape(B, S, H, hd)
    lse = lse.transpose(1, 0, 3, 2).reshape(B, S, H)
    return o, lse


def dilated_attention(h, cos, sin, w_in, q_gain, k_gain, w_out):
    B, S, _ = h.shape
    H, hd = DIL_HEADS, HEAD_DIM
    proj = (h @ w_in).reshape(B, S, N_DIL_GROUPS, 3, H, hd)
    outs, lses = [], []
    for g, (window, dilation) in enumerate(DIL_CONFIGS):
        q = apply_rope(rms_norm(proj[:, :, g, 0], q_gain[g]), cos, sin)
        k = apply_rope(rms_norm(proj[:, :, g, 1], k_gain[g]), cos, sin)
        o, lse = dilated_group(q, k, proj[:, :, g, 2], window, dilation)
        outs.append(o)
        lses.append(lse)
    alpha = jax.nn.softmax(jnp.stack(lses, axis=0), axis=0)
    o = jnp.sum(alpha[..., None] * jnp.stack(outs, axis=0).astype(jnp.float32), axis=0).astype(h.dtype)
    return o.reshape(B, S, H * hd) @ w_out


def setup_inputs(seed: int = 0) -> dict:
    key = jax.random.key(seed)
    ks = jax.random.split(key, 20)
    D = D_MODEL
    nrm = jax.random.normal
    x = nrm(ks[0], (BATCH, SEQ, D), jnp.float32)
    c = nrm(ks[1], (BATCH, D), jnp.float32)
    offs = jax.random.randint(ks[2], (BATCH, 1), 0, 4096, dtype=jnp.int32)
    positions = (offs + jnp.arange(SEQ, dtype=jnp.int32)[None, :]).astype(jnp.int32)
    mod_w = nrm(ks[3], (DEPTH, D, N_SUBLAYERS * 3 * D), jnp.float32) * (0.5 * D ** -0.5)
    mod_b = nrm(ks[4], (DEPTH, N_SUBLAYERS * 3 * D), jnp.float32) * 0.01
    norm_g = 1.0 + 0.02 * nrm(ks[5], (DEPTH, N_SUBLAYERS, D), jnp.float32)
    ffn_w_gate = nrm(ks[6], (DEPTH, 2, D, D_FF), jnp.float32) * D ** -0.5
    ffn_w_up = nrm(ks[7], (DEPTH, 2, D, D_FF), jnp.float32) * D ** -0.5
    ffn_w_down = nrm(ks[8], (DEPTH, 2, D_FF, D), jnp.float32) * D_FF ** -0.5
    fox_w_in = nrm(ks[9], (N_FOX_LAYERS, D, FOX_IN), jnp.float32) * D ** -0.5
    fox_b_f = jax.random.uniform(ks[10], (N_FOX_LAYERS, FOX_HEADS), jnp.float32, 1.0, 6.0)
    fox_q_g = 1.0 + 0.02 * nrm(ks[11], (N_FOX_LAYERS, HEAD_DIM), jnp.float32)
    fox_k_g = 1.0 + 0.02 * nrm(ks[12], (N_FOX_LAYERS, HEAD_DIM), jnp.float32)
    fox_w_out = nrm(ks[13], (N_FOX_LAYERS, FOX_HEADS * HEAD_DIM, D), jnp.float32) * (FOX_HEADS * HEAD_DIM) ** -0.5
    dil_w_in = nrm(ks[14], (N_DIL_LAYERS, D, DIL_IN), jnp.float32) * D ** -0.5
    dil_q_g = 1.0 + 0.02 * nrm(ks[15], (N_DIL_LAYERS, N_DIL_GROUPS, HEAD_DIM), jnp.float32)
    dil_k_g = 1.0 + 0.02 * nrm(ks[16], (N_DIL_LAYERS, N_DIL_GROUPS, HEAD_DIM), jnp.float32)
    dil_w_out = nrm(ks[17], (N_DIL_LAYERS, DIL_HEADS * HEAD_DIM, D), jnp.float32) * (DIL_HEADS * HEAD_DIM) ** -0.5
    return {"x": x, "c": c, "positions": positions, "mod_w": mod_w, "mod_b": mod_b,
            "norm_g": norm_g, "ffn_w_gate": ffn_w_gate, "ffn_w_up": ffn_w_up,
            "ffn_w_down": ffn_w_down, "fox_w_in": fox_w_in, "fox_b_f": fox_b_f,
            "fox_q_g": fox_q_g, "fox_k_g": fox_k_g, "fox_w_out": fox_w_out,
            "dil_w_in": dil_w_in, "dil_q_g": dil_q_g, "dil_k_g": dil_k_g, "dil_w_out": dil_w_out}


def reference(x, c, positions, mod_w, mod_b, norm_g, ffn_w_gate, ffn_w_up, ffn_w_down,
              fox_w_in, fox_b_f, fox_q_g, fox_k_g, fox_w_out,
              dil_w_in, dil_q_g, dil_k_g, dil_w_out):
    B = x.shape[0]
    D = x.shape[-1]
    cos, sin = rope_tables(positions)
    c_act = jax.nn.silu(c)
    for i in range(DEPTH):
        mod = (c_act @ mod_w[i] + mod_b[i]).reshape(B, N_SUBLAYERS, 3, D)
        shift, scale, gate = mod[:, :, 0], mod[:, :, 1], mod[:, :, 2]
        h = modulate(rms_norm(x, norm_g[i, 0]), shift[:, 0], scale[:, 0])
        x = x + MACARON_WEIGHT * gate[:, 0, None, :] * swiglu(h, ffn_w_gate[i, 0], ffn_w_up[i, 0], ffn_w_down[i, 0])
        h = modulate(rms_norm(x, norm_g[i, 1]), shift[:, 1], scale[:, 1])
        j = i // N_MIXERS
        if i % N_MIXERS == 0:
            y = fox_attention(h, fox_w_in[j], fox_b_f[j], fox_q_g[j], fox_k_g[j], fox_w_out[j])
        else:
            y = dilated_attention(h, cos, sin, dil_w_in[j], dil_q_g[j], dil_k_g[j], dil_w_out[j])
        x = x + gate[:, 1, None, :] * y
        h = modulate(rms_norm(x, norm_g[i, 2]), shift[:, 2], scale[:, 2])
        x = x + MACARON_WEIGHT * gate[:, 2, None, :] * swiglu(h, ffn_w_gate[i, 1], ffn_w_up[i, 1], ffn_w_down[i, 1])
    return x
```

```cpp
#include <hip/hip_runtime.h>
#include <hip/hip_cooperative_groups.h>
#include <cstdio>
#include <cstdint>
#include <cmath>
namespace cg = cooperative_groups;
namespace pg8 {
#define PG8_LAS __attribute__((address_space(3)))
typedef unsigned short bf16_t;
typedef short bf16x8 __attribute__((ext_vector_type(8)));
typedef float f32x4 __attribute__((ext_vector_type(4)));
typedef unsigned u32x4 __attribute__((ext_vector_type(4)));
constexpr int BM = 256, BK = 64, HALF = 128, HTB = HALF * BK * 2  , STAGE_BYTES = 8 * HTB, NXCD = 8, WGM = 8;

__host__ __device__ __forceinline__ int lds_byte(int r, int c) { const int st = (r >> 4) * 2 + (c >> 5), rr = r & 15, cc = c & 31, ob = rr * 64 + cc * 2; return st * 1024 + (ob ^ (((ob >> 9) & 1) << 5)); }
__host__ __device__ __forceinline__ void stage_rc(int b, int& R, int& C) { const int st = b / 1024, sb = b % 1024, swz = sb ^ (((sb >> 9) & 1) << 5); R = (st >> 1) * 16 + swz / 64; C = (st & 1) * 32 + (swz % 64) / 2; }
__host__ __device__ __forceinline__ int perm32(int rho) { const int n = rho >> 4, i = rho & 15; return 8 * (i >> 2) + 4 * n + (i & 3); }

struct Unit { int pm, pn; };
struct Gemm { const bf16_t* A; const bf16_t* Bt; int M, N, K; };

struct StaticOrder {
    int nM, nN, nwg, G, c;
    __host__ __device__ void init(int M, int N, int G_, int c_) { nM = M / BM; nN = N / BM; nwg = nM * nN; G = G_; c = c_; }
    __host__ __device__ bool next(int i, Unit& u) const {
        const long L = (long)i * G + c; if (L >= nwg) return false;
        int wgid = (int)L; { const int q = nwg / NXCD, r = nwg % NXCD, xcd = wgid % NXCD, off = wgid / NXCD; wgid = (xcd < r ? xcd * (q + 1) : r * (q + 1) + (xcd - r) * q) + off; }
        const int nig = WGM * nN, gid = wgid / nig, fm = gid * WGM, gsz = (nM - fm) < WGM ? (nM - fm) : WGM;
        u.pm = fm + ((wgid % nig) % gsz); u.pn = (wgid % nig) / gsz; return true;
    }
    __device__ __forceinline__ void a_ready(const Unit&) const {}
    __device__ __forceinline__ void done(const Unit&) const {}
};

__device__ __forceinline__ unsigned cvt_pk_bf16(float lo, float hi) { unsigned r; asm volatile("v_cvt_pk_bf16_f32 %0, %1, %2" : "=v"(r) : "v"(lo), "v"(hi)); return r; }
typedef float f32x2 __attribute__((ext_vector_type(2)));
constexpr int P_MT = 32768, P_DM = 1024, P_FF = 2816, P_MODN = 9216;
constexpr float P_C2 = 0.125f * 1.4426950408889634f;

struct EpiSwiGLU {
    static constexpr bool PERM = true, AFTER_DRAIN = false;
    bf16_t* Hd;
    __device__ __forceinline__ void operator()(const f32x4 (&acc)[2][2][4][2], const Unit& u, int wr, int wc, int fr, int fq) const {
        const int row0 = u.pm * BM + wr * 64 + fr, col0 = u.pn * 128 + wc * 32 + 8 * fq;
#pragma unroll
        for (int ai = 0; ai < 2; ++ai)
#pragma unroll
            for (int m = 0; m < 4; ++m) {
                bf16_t* rowp = Hd + (size_t)(row0 + ai * HALF + m * 16) * P_FF + col0;
                float v[8];
#pragma unroll
                for (int n = 0; n < 2; ++n)
#pragma unroll
                    for (int e = 0; e < 4; ++e) {
                        const float g = acc[ai][0][m][n][e], up = acc[ai][1][m][n][e];
                        const float s = __builtin_amdgcn_rcpf(1.0f + __builtin_amdgcn_exp2f(-1.4426950408889634f * g));
                        v[n * 4 + e] = g * s * up;
                    }
                u32x4 w; w.x = cvt_pk_bf16(v[0], v[1]); w.y = cvt_pk_bf16(v[2], v[3]); w.z = cvt_pk_bf16(v[4], v[5]); w.w = cvt_pk_bf16(v[6], v[7]);
                *(u32x4*)rowp = w;
            }
    }
};

struct EpiResid {
    static constexpr bool PERM = true, AFTER_DRAIN = false;
    const float* xin; float* xout; const float* coef;
    __device__ __forceinline__ void operator()(const f32x4 (&acc)[2][2][4][2], const Unit& u, int wr, int wc, int fr, int fq) const {
        const int row0 = u.pm * BM + wr * 64 + fr, col0 = u.pn * BM + wc * 32 + 8 * fq;
        const float* cf = coef + (size_t)(u.pm >> 4) * P_MODN + col0;
        f32x4 cv[2][2];
#pragma unroll
        for (int bj = 0; bj < 2; ++bj)
#pragma unroll
            for (int n = 0; n < 2; ++n) cv[bj][n] = *(const f32x4*)(cf + bj * HALF + n * 4);
#pragma unroll
        for (int ai = 0; ai < 2; ++ai)
#pragma unroll
            for (int m = 0; m < 4; ++m) {
                const size_t off = (size_t)(row0 + ai * HALF + m * 16) * P_DM + col0;
#pragma unroll
                for (int bj = 0; bj < 2; ++bj)
#pragma unroll
                    for (int n = 0; n < 2; ++n) {
                        const f32x4 xi = *(const f32x4*)(xin + off + bj * HALF + n * 4);
                        *(f32x4*)(xout + off + bj * HALF + n * 4) = xi + cv[bj][n] * acc[ai][bj][m][n];
                    }
            }
    }
};

struct EpiQKV {
    static constexpr bool PERM = true, AFTER_DRAIN = false;
    bf16_t* out; int fox; const float* qg; const float* kg; const float* cs; const float* sn;
    __device__ __forceinline__ void operator()(const f32x4 (&acc)[2][2][4][2], const Unit& u, int wr, int wc, int fr, int fq) const {
        int which, colbase, pitch; bf16_t* base; const float* gq; const float* gk;
        if (fox) { which = u.pn >> 2; base = out + (size_t)which * ((size_t)P_MT * P_DM); pitch = P_DM; colbase = (u.pn & 3) * 256; gq = qg; gk = kg; }
        else { const int grp = u.pn / 12; which = (u.pn % 12) >> 2; base = out; pitch = 9216; colbase = u.pn * 256; gq = qg + grp * 64; gk = kg + grp * 64; }
        const int row0 = u.pm * BM + wr * 64 + fr;
        const int cw = colbase + wc * 64 + 8 * fq;
        if (which == 2) {
#pragma unroll
            for (int ai = 0; ai < 2; ++ai)
#pragma unroll
                for (int m = 0; m < 4; ++m) {
                    bf16_t* rowp = base + (size_t)(row0 + ai * HALF + m * 16) * pitch + cw;
#pragma unroll
                    for (int bj = 0; bj < 2; ++bj) {
                        const f32x4 v0 = acc[ai][bj][m][0], v1 = acc[ai][bj][m][1];
                        u32x4 w; w.x = cvt_pk_bf16(v0[0], v0[1]); w.y = cvt_pk_bf16(v0[2], v0[3]); w.z = cvt_pk_bf16(v1[0], v1[1]); w.w = cvt_pk_bf16(v1[2], v1[3]);
                        *(u32x4*)(rowp + bj * 32) = w;
                    }
                }
        } else {
            const float* gp = (which == 0) ? gq : gk; const float osc = (which == 0) ? P_C2 : 1.0f;
            f32x4 gv[2][2];
#pragma unroll
            for (int bj = 0; bj < 2; ++bj)
#pragma unroll
                for (int n = 0; n < 2; ++n) gv[bj][n] = *(const f32x4*)(gp + 32 * bj + 8 * fq + 4 * n) * osc;
#pragma unroll
            for (int ai = 0; ai < 2; ++ai)
#pragma unroll
                for (int m = 0; m < 4; ++m) {
                    const int row = row0 + ai * HALF + m * 16;
                    f32x4 v[2][2]; float ss = 0.f;
#pragma unroll
                    for (int bj = 0; bj < 2; ++bj)
#pragma unroll
                        for (int n = 0; n < 2; ++n) { v[bj][n] = acc[ai][bj][m][n]; const f32x4 t = v[bj][n] * v[bj][n]; ss += (t[0] + t[1]) + (t[2] + t[3]); }
                    ss += __shfl_xor(ss, 16); ss += __shfl_xor(ss, 32);
                    const float rstd = 1.0f / sqrtf(ss * (1.0f / 64.0f) + 1e-6f);
#pragma unroll
                    for (int bj = 0; bj < 2; ++bj)
#pragma unroll
                        for (int n = 0; n < 2; ++n) v[bj][n] = v[bj][n] * rstd * gv[bj][n];
                    if (!fox) {
#pragma unroll
                        for (int n = 0; n < 2; ++n) {
                            const f32x4 c = *(const f32x4*)(cs + (size_t)row * 8 + 4 * n), s = *(const f32x4*)(sn + (size_t)row * 8 + 4 * n);
                            f32x4 oth;
#pragma unroll
                            for (int e = 0; e < 4; ++e) oth[e] = __shfl_xor(v[0][n][e], 16);
                            const f32x4 r0 = v[0][n] * c - oth * s, r1 = v[0][n] * c + oth * s;
                            v[0][n] = (fq == 0) ? r0 : ((fq == 1) ? r1 : v[0][n]);
                        }
                    }
                    bf16_t* rowp = base + (size_t)row * pitch + cw;
#pragma unroll
                    for (int bj = 0; bj < 2; ++bj) {
                        const f32x4 v0 = v[bj][0], v1 = v[bj][1];
                        u32x4 w; w.x = cvt_pk_bf16(v0[0], v0[1]); w.y = cvt_pk_bf16(v0[2], v0[3]); w.z = cvt_pk_bf16(v1[0], v1[1]); w.w = cvt_pk_bf16(v1[2], v1[3]);
                        *(u32x4*)(rowp + bj * 32) = w;
                    }
                }
        }
    }
};

struct EpiAny {
    static constexpr bool PERM = true, AFTER_DRAIN = false;
    int kind; EpiSwiGLU s; EpiResid r; EpiQKV q;
    __device__ __forceinline__ void operator()(const f32x4 (&acc)[2][2][4][2], const Unit& u, int wr, int wc, int fr, int fq) const {
        if (kind == 0) s(acc, u, wr, wc, fr, fq); else if (kind == 1) r(acc, u, wr, wc, fr, fq); else q(acc, u, wr, wc, fr, fq);
    }
};
template <class Epi, class Sched, bool ALIGN_EPI = false, bool SP2 = false>
__device__ __forceinline__ void gemm_phase(PG8_LAS unsigned char* lds, const Gemm g, const Sched& S, const Epi& E) {
    int tid_ = threadIdx.x; asm volatile("" : "+v"(tid_)); const int tid = tid_, wid = __builtin_amdgcn_readfirstlane(tid >> 6), lane = tid & 63, wr = wid >> 2, wc = wid & 3, fr = lane & 15, fq = lane >> 4;
    const int K = g.K, nt = K / BK;
    unsigned voffA[2], voffB[2];
#pragma unroll
    for (int i = 0; i < 2; ++i) { int R, C; stage_rc(tid * 16 + i * 8192, R, C); const int Rb = Epi::PERM ? ((R & ~31) + perm32(R & 31)) : R;
        voffA[i] = (unsigned)(R * K + C) * 2u; voffB[i] = (unsigned)(Rb * K + C) * 2u; }
    const size_t kstep = (size_t)(BK * 2);
    const size_t hstep = (size_t)HALF * K * 2;
    const size_t tstep = 2 * hstep;
    const unsigned ldsw = (unsigned)wid * 1024u;
    const int aoff = lds_byte(wr * 64 + fr, fq * 8), boff = lds_byte(wc * 32 + fr, fq * 8);
#define PG8_SA(b, h) (((b) * 2 + (h)) * HTB)
#define PG8_SB(b, h) ((4 + (b) * 2 + (h)) * HTB)
#define PG8_STAGE(bufoff, gbase, voff) do { _Pragma("unroll") for (int _i = 0; _i < 2; ++_i) \
        __builtin_amdgcn_global_load_lds((const unsigned*)((const char*)(gbase) + (voff)[_i]), (PG8_LAS unsigned*)(lds + (bufoff) + ldsw + _i * 8192), 16, 0, 0); } while (0)
#define PG8_LDA(dst, b, h) do { _Pragma("unroll") for (int m = 0; m < 4; ++m) _Pragma("unroll") for (int k = 0; k < 2; ++k) dst[m][k] = *(const PG8_LAS bf16x8*)(lds + PG8_SA(b, h) + aoff + m * 2048 + k * 1024); } while (0)
#define PG8_LDB(dst, b, h) do { _Pragma("unroll") for (int n = 0; n < 2; ++n) _Pragma("unroll") for (int k = 0; k < 2; ++k) dst[n][k] = *(const PG8_LAS bf16x8*)(lds + PG8_SB(b, h) + boff + n * 2048 + k * 1024); } while (0)
#define PG8_MMA(ai, bj, At, Bt) do { __builtin_amdgcn_s_setprio(1); _Pragma("unroll") for (int m = 0; m < 4; ++m) _Pragma("unroll") for (int n = 0; n < 2; ++n) _Pragma("unroll") for (int k = 0; k < 2; ++k) \
        acc[ai][bj][m][n] = __builtin_amdgcn_mfma_f32_16x16x32_bf16(Bt[n][k], At[m][k], acc[ai][bj][m][n], 0, 0, 0); __builtin_amdgcn_s_setprio(0); } while (0)
#define PG8_WAIT_V(n) asm volatile("s_waitcnt vmcnt(" #n ")" ::: "memory")
#define PG8_WAIT_L(n) asm volatile("s_waitcnt lgkmcnt(" #n ")" ::: "memory")
#define PG8_BAR __builtin_amdgcn_s_barrier()
#define PG8_SCHED __builtin_amdgcn_sched_barrier(0)
    Unit cur, nxt; int ui = 0;
    if (!S.next(0, cur)) return;
    f32x4 acc[2][2][4][2];
#pragma unroll
    for (int a = 0; a < 2; ++a)
#pragma unroll
        for (int b = 0; b < 2; ++b)
#pragma unroll
            for (int m = 0; m < 4; ++m)
#pragma unroll
                for (int n = 0; n < 2; ++n) acc[a][b][m][n] = (f32x4){0.f, 0.f, 0.f, 0.f};
    bf16x8 At[4][2], B0[2][2], B1[2][2];
    const char* cA = (const char*)g.A + (size_t)cur.pm * tstep; const char* cB = (const char*)g.Bt + (size_t)cur.pn * tstep;
    S.a_ready(cur);
    if constexpr (SP2) {
        PG8_STAGE(PG8_SB(0, 0), cB, voffB); PG8_STAGE(PG8_SB(0, 1), cB + hstep, voffB); PG8_STAGE(PG8_SA(0, 0), cA, voffA); PG8_STAGE(PG8_SA(0, 1), cA + hstep, voffA);
        if (wr == 1) PG8_BAR;
        PG8_WAIT_V(2); PG8_BAR;
        PG8_STAGE(PG8_SB(1, 0), cB + kstep, voffB); PG8_STAGE(PG8_SA(1, 0), cA + kstep, voffA); PG8_STAGE(PG8_SB(1, 1), cB + hstep + kstep, voffB);
        PG8_WAIT_V(6); PG8_BAR;
    } else {
        PG8_STAGE(PG8_SB(0, 0), cB, voffB); PG8_STAGE(PG8_SA(0, 0), cA, voffA); PG8_STAGE(PG8_SB(0, 1), cB + hstep, voffB); PG8_STAGE(PG8_SA(0, 1), cA + hstep, voffA);
        if (wr == 1) PG8_BAR;
        PG8_WAIT_V(4); PG8_BAR;
        PG8_STAGE(PG8_SB(1, 0), cB + kstep, voffB); PG8_STAGE(PG8_SA(1, 0), cA + kstep, voffA); PG8_STAGE(PG8_SB(1, 1), cB + hstep + kstep, voffB);
        PG8_WAIT_V(6); PG8_BAR;
    }
    for (;;) {
        const bool has_next = S.next(ui + 1, nxt);
        const char* nA = has_next ? (const char*)g.A + (size_t)nxt.pm * tstep : cA; const char* nB = has_next ? (const char*)g.Bt + (size_t)nxt.pn * tstep : cB;
        for (int t = 0; t < nt; t += 2) {
            const bool last = (t == nt - 2);
            const char* a1 = cA + (size_t)(t + 1) * kstep;
            const char* a2 = last ? nA : cA + (size_t)(t + 2) * kstep; const char* b2 = last ? nB : cB + (size_t)(t + 2) * kstep;
            const char* a3 = a2 + kstep; const char* b3 = b2 + kstep;
            if (last && has_next) S.a_ready(nxt);
            if constexpr (SP2) {
            PG8_LDB(B0, 0, 0); PG8_LDB(B1, 0, 1); PG8_SCHED; PG8_LDA(At, 0, 0); PG8_STAGE(PG8_SA(1, 1), a1 + hstep, voffA);
            PG8_WAIT_V(8); PG8_WAIT_L(0); PG8_BAR; PG8_MMA(0, 0, At, B0); PG8_MMA(0, 1, At, B1); PG8_BAR; PG8_SCHED;
            PG8_LDA(At, 0, 1); PG8_STAGE(PG8_SB(0, 0), b2, voffB); PG8_STAGE(PG8_SB(0, 1), b2 + hstep, voffB); PG8_STAGE(PG8_SA(0, 0), a2, voffA);
            PG8_WAIT_V(8); PG8_WAIT_L(0); PG8_BAR; PG8_MMA(1, 0, At, B0); PG8_MMA(1, 1, At, B1); PG8_BAR; PG8_SCHED;
            PG8_LDB(B0, 1, 0); PG8_LDB(B1, 1, 1); PG8_SCHED; PG8_LDA(At, 1, 0); PG8_STAGE(PG8_SA(0, 1), a2 + hstep, voffA);
            PG8_WAIT_V(8); PG8_WAIT_L(0); PG8_BAR; PG8_MMA(0, 0, At, B0); PG8_MMA(0, 1, At, B1); PG8_BAR; PG8_SCHED;
            PG8_LDA(At, 1, 1); PG8_STAGE(PG8_SB(1, 0), b3, voffB); PG8_STAGE(PG8_SB(1, 1), b3 + hstep, voffB); PG8_STAGE(PG8_SA(1, 0), a3, voffA);
            PG8_WAIT_V(8); PG8_WAIT_L(0); PG8_BAR; PG8_MMA(1, 0, At, B0); PG8_MMA(1, 1, At, B1); PG8_BAR; PG8_SCHED;
            } else {
            PG8_LDB(B0, 0, 0); PG8_SCHED; PG8_LDA(At, 0, 0); PG8_STAGE(PG8_SA(1, 1), a1 + hstep, voffA);
            PG8_WAIT_L(8); PG8_BAR; PG8_WAIT_L(0); PG8_MMA(0, 0, At, B0); PG8_BAR; PG8_SCHED;
            PG8_LDB(B1, 0, 1); PG8_STAGE(PG8_SB(0, 0), b2, voffB);
            PG8_BAR; PG8_WAIT_L(0); PG8_MMA(0, 1, At, B1); PG8_BAR;
            PG8_LDA(At, 0, 1); PG8_STAGE(PG8_SA(0, 0), a2, voffA);
            PG8_BAR; PG8_WAIT_L(0); PG8_MMA(1, 0, At, B0); PG8_BAR; PG8_SCHED;
            PG8_STAGE(PG8_SB(0, 1), b2 + hstep, voffB);
            PG8_WAIT_V(6); PG8_BAR; PG8_MMA(1, 1, At, B1); PG8_BAR;
            PG8_LDB(B0, 1, 0); PG8_SCHED; PG8_LDA(At, 1, 0); PG8_STAGE(PG8_SA(0, 1), a2 + hstep, voffA);
            PG8_WAIT_L(8); PG8_BAR; PG8_WAIT_L(0); PG8_MMA(0, 0, At, B0); PG8_BAR; PG8_SCHED;
            PG8_LDB(B1, 1, 1); PG8_STAGE(PG8_SB(1, 0), b3, voffB);
            PG8_BAR; PG8_WAIT_L(0); PG8_MMA(0, 1, At, B1); PG8_BAR;
            PG8_LDA(At, 1, 1); PG8_STAGE(PG8_SA(1, 0), a3, voffA);
            PG8_BAR; PG8_WAIT_L(0); PG8_MMA(1, 0, At, B0); PG8_BAR; PG8_SCHED;
            PG8_STAGE(PG8_SB(1, 1), b3 + hstep, voffB);
            PG8_WAIT_V(6); PG8_BAR; PG8_MMA(1, 1, At, B1); PG8_BAR;
            }
        }
        if constexpr (ALIGN_EPI) { if (wr == 0) PG8_BAR; }
        if constexpr (!Epi::AFTER_DRAIN) { E(acc, cur, wr, wc, fr, fq); S.done(cur); }
        if (!has_next) break;
#pragma unroll
        for (int a = 0; a < 2; ++a)
#pragma unroll
            for (int b = 0; b < 2; ++b)
#pragma unroll
                for (int m = 0; m < 4; ++m)
#pragma unroll
                    for (int n = 0; n < 2; ++n) acc[a][b][m][n] = (f32x4){0.f, 0.f, 0.f, 0.f};
        cur = nxt; cA = nA; cB = nB; ++ui;
        if constexpr (ALIGN_EPI) { if (wr == 1) PG8_BAR; }
    }
    PG8_WAIT_V(0);
    if constexpr (!ALIGN_EPI) { if (wr == 0) PG8_BAR; }
    PG8_BAR;
    if constexpr (Epi::AFTER_DRAIN) { E.fused(acc, cur, wr, wc, fr, fq, lds, wid, lane); S.done(cur); }
#undef PG8_SA
#undef PG8_SB
#undef PG8_STAGE
#undef PG8_LDA
#undef PG8_LDB
#undef PG8_MMA
#undef PG8_WAIT_V
#undef PG8_WAIT_L
#undef PG8_BAR
#undef PG8_SCHED
}
}
namespace att {
#define LAS __attribute__((address_space(3)))
typedef unsigned short bf16_t;
typedef short bf16x8 __attribute__((ext_vector_type(8)));
typedef short s16x4 __attribute__((ext_vector_type(4)));
typedef short v4i16_t __attribute__((ext_vector_type(4)));
typedef float f32x4 __attribute__((ext_vector_type(4)));
typedef float f32x16 __attribute__((ext_vector_type(16)));
typedef unsigned u32x4 __attribute__((ext_vector_type(4)));
constexpr int KOFF = 0, VOFF = 16384, CUM_OFF = 32768, WSF_OFF = 49152, PF_OFF = 51200;
constexpr float LOG2E = 1.4426950408889634f;
__device__ __forceinline__ int crow(int r, int hi) { return (r & 3) + 8 * (r >> 2) + 4 * hi; }
__device__ __forceinline__ unsigned cvtpk(float lo, float hi) { unsigned r; asm volatile("v_cvt_pk_bf16_f32 %0, %1, %2" : "=v"(r) : "v"(lo), "v"(hi)); return r; }
__device__ __forceinline__ s16x4 vtr(const LAS unsigned char* p) { return __builtin_bit_cast(s16x4, __builtin_amdgcn_ds_read_tr16_b64_v4i16((LAS v4i16_t*)p)); }

struct Unit {
    const bf16_t* Q; const bf16_t* K; const bf16_t* V; bf16_t* O;
    long stride;
    int q0, t_lo, t_hi, window;
    int bias;
    float* lse; long lse_stride;
};

__device__ __forceinline__ void unit_run(LAS unsigned char* lds, const Unit& U) {
    int tid_ = threadIdx.x; asm volatile("" : "+v"(tid_)); const int tid = tid_, lane = tid & 63, r32 = lane & 31, hi = lane >> 5;
    const int wid = __builtin_amdgcn_readfirstlane(tid >> 6);
    const int srow = tid >> 3, sch = tid & 7;
    const bf16_t* kg = U.K + (long)srow * U.stride + sch * 8;
    const bf16_t* vg = U.V + (long)srow * U.stride + sch * 8;
    const int kst = KOFF + sch * 1024 + srow * 16;
    const int vst = VOFF + (sch >> 2) * 4096 + srow * 64 + (sch & 3) * 16;
    const int uq = U.q0 + wid * 32 + r32;
    bf16x8 qr[4];
#pragma unroll
    for (int d0 = 0; d0 < 4; ++d0) qr[d0] = *(const bf16x8*)(U.Q + (long)uq * U.stride + d0 * 16 + hi * 8);
    float m = -1e30f, l = 0.f;
    f32x16 o0, o1;
#pragma unroll
    for (int r = 0; r < 16; ++r) { o0[r] = 0.f; o1[r] = 0.f; }
    LAS float* wsf = (LAS float*)(lds + WSF_OFF) + wid * 64;
    const LAS float* cumL = (const LAS float*)(lds + CUM_OFF);
    const int wq_lo = U.q0 + wid * 32, wq_hi = wq_lo + 31;
    u32x4 kreg, vreg;
    {
        const long go = (long)U.t_lo * 64 * U.stride;
        kreg = *(const u32x4*)(kg + go); vreg = *(const u32x4*)(vg + go);
        *(LAS u32x4*)(lds + kst) = kreg; *(LAS u32x4*)(lds + vst) = vreg;
    }
    const LAS unsigned char* vp0 = lds + VOFF + ((lane >> 4) & 1) * 32 + (lane & 3) * 8 + (4 * hi + ((lane & 15) >> 2)) * 64;
    const LAS unsigned char* kp0 = lds + KOFF + hi * 1024 + r32 * 16;
    for (int t = U.t_lo; t < U.t_hi; ++t) {
        const int cur = (t - U.t_lo) & 1;
        const bool more = (t + 1 < U.t_hi);
        if (more) { const long go = (long)(t + 1) * 64 * U.stride; kreg = *(const u32x4*)(kg + go); vreg = *(const u32x4*)(vg + go); }
        __syncthreads();
        const bool need = (64 * t <= wq_hi) && (64 * t + 63 >= wq_lo - U.window);
        if (need) {
            const LAS unsigned char* kb = kp0 + cur * 8192;
            f32x16 p0, p1;
#pragma unroll
            for (int r = 0; r < 16; ++r) { p0[r] = 0.f; p1[r] = 0.f; }
#pragma unroll
            for (int d0 = 0; d0 < 4; ++d0) {
                const bf16x8 b0 = *(const LAS bf16x8*)(kb + d0 * 2048), b1 = *(const LAS bf16x8*)(kb + d0 * 2048 + 512);
                p0 = __builtin_amdgcn_mfma_f32_32x32x16_bf16(b0, qr[d0], p0, 0, 0, 0);
                p1 = __builtin_amdgcn_mfma_f32_32x32x16_bf16(b1, qr[d0], p1, 0, 0, 0);
            }
            if (U.bias) {
#pragma unroll
                for (int g = 0; g < 4; ++g) {
                    const f32x4 c0 = *(const LAS f32x4*)(cumL + 64 * t + 8 * g + 4 * hi), c1 = *(const LAS f32x4*)(cumL + 64 * t + 32 + 8 * g + 4 * hi);
#pragma unroll
                    for (int e = 0; e < 4; ++e) { p0[4 * g + e] += c0[e]; p1[4 * g + e] += c1[e]; }
                }
            }
            const bool need_mask = (64 * t + 63 > wq_lo) || (64 * t < wq_hi - U.window);
            if (need_mask) {
                const int lo_ok = uq - U.window;
#pragma unroll
                for (int r = 0; r < 16; ++r) {
                    const int kv = 64 * t + crow(r, hi);
                    if (kv > uq || kv < lo_ok) p0[r] = -INFINITY;
                    if (kv + 32 > uq || kv + 32 < lo_ok) p1[r] = -INFINITY;
                }
            }
            float mx = fmaxf(p0[0], p1[0]);
#pragma unroll
            for (int r = 1; r < 16; ++r) mx = fmaxf(mx, fmaxf(p0[r], p1[r]));
            mx = fmaxf(mx, __shfl_xor(mx, 32));
            const float mn = fmaxf(m, mx);
            const float alpha = __builtin_amdgcn_exp2f(m - mn);
            m = mn;
            float rs = 0.f;
#pragma unroll
            for (int r = 0; r < 16; ++r) { p0[r] = __builtin_amdgcn_exp2f(p0[r] - mn); p1[r] = __builtin_amdgcn_exp2f(p1[r] - mn); rs += p0[r] + p1[r]; }
            l = l * alpha + rs;
            if (hi == 0) wsf[r32] = alpha;
#pragma unroll
            for (int g = 0; g < 4; ++g) {
                const f32x4 a = *(const LAS f32x4*)(wsf + 8 * g + 4 * hi);
#pragma unroll
                for (int e = 0; e < 4; ++e) { o0[4 * g + e] *= a[e]; o1[4 * g + e] *= a[e]; }
            }
            u32x4 pw[4];
#pragma unroll
            for (int c = 0; c < 4; ++c) {
                pw[0][c] = cvtpk(p0[2 * c], p0[2 * c + 1]); pw[1][c] = cvtpk(p0[8 + 2 * c], p0[8 + 2 * c + 1]);
                pw[2][c] = cvtpk(p1[2 * c], p1[2 * c + 1]); pw[3][c] = cvtpk(p1[8 + 2 * c], p1[8 + 2 * c + 1]);
            }
            const LAS unsigned char* vp = vp0 + cur * 8192;
#pragma unroll
            for (int ks = 0; ks < 4; ++ks) {
                const s16x4 a0 = vtr(vp + ks * 1024), a1 = vtr(vp + ks * 1024 + 512), c0 = vtr(vp + 4096 + ks * 1024), c1 = vtr(vp + 4096 + ks * 1024 + 512);
                const bf16x8 pa = __builtin_bit_cast(bf16x8, pw[ks]);
                const bf16x8 v0 = (bf16x8){a0[0], a0[1], a0[2], a0[3], a1[0], a1[1], a1[2], a1[3]};
                const bf16x8 v1 = (bf16x8){c0[0], c0[1], c0[2], c0[3], c1[0], c1[1], c1[2], c1[3]};
                o0 = __builtin_amdgcn_mfma_f32_32x32x16_bf16(pa, v0, o0, 0, 0, 0);
                o1 = __builtin_amdgcn_mfma_f32_32x32x16_bf16(pa, v1, o1, 0, 0, 0);
            }
        }
        if (more) { *(LAS u32x4*)(lds + kst + (cur ^ 1) * 8192) = kreg; *(LAS u32x4*)(lds + vst + (cur ^ 1) * 8192) = vreg; }
    }
    l += __shfl_xor(l, 32);
    if (hi == 0) { wsf[32 + r32] = l; if (U.lse) U.lse[(long)uq * U.lse_stride] = m + __builtin_amdgcn_logf(l); }
    bf16_t* Ow = U.O + (long)(U.q0 + wid * 32) * U.stride;
#pragma unroll
    for (int g = 0; g < 4; ++g) {
        const f32x4 lv = *(const LAS f32x4*)(wsf + 32 + 8 * g + 4 * hi);
#pragma unroll
        for (int e = 0; e < 4; ++e) {
            const int r = 4 * g + e; const float rl = 1.0f / lv[e];
            bf16_t* op = Ow + (long)crow(r, hi) * U.stride + r32;
            const unsigned w0 = cvtpk(o0[r] * rl, 0.f), w1 = cvtpk(o1[r] * rl, 0.f);
            op[0] = (bf16_t)(w0 & 0xffffu); op[32] = (bf16_t)(w1 & 0xffffu);
        }
    }
}
#undef LAS
}
#define LAS __attribute__((address_space(3)))
typedef unsigned short bf16_t;
typedef float f32x4 __attribute__((ext_vector_type(4)));
typedef unsigned u32x4 __attribute__((ext_vector_type(4)));
typedef unsigned u32x2 __attribute__((ext_vector_type(2)));

constexpr int NB = 8, SEQ = 4096, DM = 1024, MT = NB * SEQ, FF = 2816, NH = 16, MODN = 9216;
constexpr int NTHREADS = 512, NWAVES = 8;
constexpr float LOG2E = 1.4426950408889634f;
constexpr size_t MiB = (size_t)1 << 20;
constexpr size_t WS_MOD = 1 * MiB, WS_COS = 3 * MiB, WS_SIN = 4 * MiB, WS_CUM = 5 * MiB, WS_CHT = 7 * MiB, WS_LSE = 8 * MiB;
constexpr size_t WS_W = 16 * MiB, FFN_BLK = (size_t)(2 * FF * DM + DM * FF) * 2, FFN_DOWN_OFF = (size_t)2 * FF * DM * 2;
constexpr size_t WS_FOXIN = WS_W + 8 * FFN_BLK, FOXIN_SZ = (size_t)3072 * DM * 2;
constexpr size_t WS_FOXOUT = WS_FOXIN + 2 * FOXIN_SZ, OUT_SZ = (size_t)DM * DM * 2;
constexpr size_t WS_DILIN = WS_FOXOUT + 2 * OUT_SZ, DILIN_SZ = (size_t)9216 * DM * 2;
constexpr size_t WS_DILOUT = WS_DILIN + 2 * DILIN_SZ;
constexpr size_t WS_H = WS_DILOUT + 2 * OUT_SZ;
constexpr size_t WS_BIG = WS_H + (size_t)MT * DM * 2;
constexpr size_t WS_END = WS_BIG + (size_t)(MT / 2) * 9216 * 2;
static_assert(WS_W + 8 * FFN_BLK == 148 * MiB && WS_H == 204 * MiB && WS_END == 556 * MiB, "workspace map");
constexpr int LDS_BYTES = 147456;

__device__ __forceinline__ unsigned f2bf(float f) { unsigned u = __builtin_bit_cast(unsigned, f); return (u + 0x7fffu + ((u >> 16) & 1u)) >> 16; }
__device__ __forceinline__ unsigned pk2(float lo, float hi) { return f2bf(lo) | (f2bf(hi) << 16); }
__device__ __forceinline__ float bflo(unsigned w) { return __builtin_bit_cast(float, w << 16); }
__device__ __forceinline__ float bfhi(unsigned w) { return __builtin_bit_cast(float, w & 0xffff0000u); }
__device__ __forceinline__ float wave_sum(float v) {
#pragma unroll
    for (int o = 1; o < 64; o <<= 1) v += __shfl_xor(v, o);
    return v;
}

__device__ __forceinline__ int fresh_tid() { int t = threadIdx.x; asm volatile("" : "+v"(t)); return t; }
struct Args { const void* in[18]; float* out; unsigned char* ws; int ph_lo, ph_hi; };

__device__ __forceinline__ int map_row(int kind, int n0) {
    if (kind == 0) return n0;
    if (kind == 1) return 256 * (n0 >> 7) + (n0 & 127);
    if (kind == 2) return 256 * (n0 >> 7) + 128 + (n0 & 127);
    return (n0 & ~255) + 128 * ((n0 >> 5) & 1) + 32 * ((n0 >> 6) & 3);
}
__device__ __forceinline__ void conv_item(const float* W, int K, int Npitch, int nblk, bf16_t* WT, int kind, LAS float* scr, int item, int lane) {
    const int kb = item / nblk, nb = item % nblk, k0 = 64 * kb, n0 = 32 * nb;
    const int drow0 = map_row(kind, n0);
#pragma unroll 8
    for (int i = 0; i < 32; ++i) { const int kk = 2 * i + (lane >> 5); scr[kk * 33 + (lane & 31)] = W[(size_t)(k0 + kk) * Npitch + n0 + (lane & 31)]; }
    asm volatile("s_waitcnt lgkmcnt(0)" ::: "memory");
    const int c = lane & 7;
#pragma unroll
    for (int j = 0; j < 4; ++j) { const int n = (lane >> 3) + 8 * j; const LAS float* s = scr + (8 * c) * 33 + n;
        u32x4 o; o.x = pk2(s[0 * 33], s[1 * 33]); o.y = pk2(s[2 * 33], s[3 * 33]); o.z = pk2(s[4 * 33], s[5 * 33]); o.w = pk2(s[6 * 33], s[7 * 33]);
        *(u32x4*)(WT + (size_t)(drow0 + n) * K + k0 + 8 * c) = o; }
    asm volatile("s_waitcnt lgkmcnt(0)" ::: "memory");
}

template <class AT> __device__ __forceinline__ void prologue_phase(AT& a, LAS unsigned char* lds) {
    const int tid = fresh_tid(), lane = tid & 63, wid = __builtin_amdgcn_readfirstlane(tid >> 6);
    const int G = gridDim.x, bid = blockIdx.x;
    unsigned char* ws = a.ws;
    {
        const float* c = (const float*)a.in[1]; const float* mod_w = (const float*)a.in[3]; const float* mod_b = (const float*)a.in[4];
        float* modbuf = (float*)(ws + WS_MOD);
        LAS float* cact = (LAS float*)lds;
        LAS float* red = (LAS float*)(lds + 32768);
        for (int e = tid; e < NB * DM; e += NTHREADS) { const int b = e >> 10, k = e & 1023; const float v = c[e]; cact[k * 8 + b] = v / (1.0f + __expf(-v)); }
        __syncthreads();
        for (int task = bid; task < 4 * 144; task += G) {
            const int i = task / 144, n0 = (task % 144) * 64, n = n0 + lane;
            float acc[8];
#pragma unroll
            for (int b = 0; b < 8; ++b) acc[b] = 0.f;
            const float* wp = mod_w + ((size_t)i * DM + 128 * wid) * MODN + n;
#pragma unroll 4
            for (int kk = 0; kk < 128; ++kk) {
                const float wv = wp[(size_t)kk * MODN];
                const f32x4 c0 = *(const LAS f32x4*)(cact + (128 * wid + kk) * 8), c1 = *(const LAS f32x4*)(cact + (128 * wid + kk) * 8 + 4);
                acc[0] += c0[0] * wv; acc[1] += c0[1] * wv; acc[2] += c0[2] * wv; acc[3] += c0[3] * wv;
                acc[4] += c1[0] * wv; acc[5] += c1[1] * wv; acc[6] += c1[2] * wv; acc[7] += c1[3] * wv;
            }
#pragma unroll
            for (int b = 0; b < 8; ++b) red[(wid * 8 + b) * 64 + lane] = acc[b];
            __syncthreads();
            {
                const int b = tid >> 6; float s = 0.f;
#pragma unroll
                for (int w = 0; w < 8; ++w) s += red[(w * 8 + b) * 64 + lane];
                s += mod_b[(size_t)i * MODN + n];
                const int sidx = n / 3072, j = (n >> 10) % 3;
                if (j == 1) s += 1.0f;
                if (j == 2 && sidx != 1) s *= 0.5f;
                modbuf[((size_t)i * NB + b) * MODN + n] = s;
            }
            __syncthreads();
        }
    }
    __syncthreads();
    {
        const int* pos = (const int*)a.in[2];
        float* cs = (float*)(ws + WS_COS); float* sn = (float*)(ws + WS_SIN);
        for (int e = bid * NTHREADS + tid; e < MT * 8; e += G * NTHREADS) {
            const int i = e & 7;
            const float invf = (i == 0) ? 1.0f : (i == 1) ? 0.1939227432012558f : (i == 2) ? 0.03760603070259094f : (i == 3) ? 0.007292664609849453f
                             : (i == 4) ? 0.0014142135623842478f : (i == 5) ? 0.00027424818836152554f : (i == 6) ? 5.3182957344688475e-05f : 1.0313385246263351e-05f;
            const float ang = (float)pos[e >> 3] * invf;
            const double rev = (double)ang * 0.15915494309189535;
            const float fr = (float)(rev - floor(rev));
            cs[e] = __builtin_amdgcn_cosf(fr); sn[e] = __builtin_amdgcn_sinf(fr);
        }
    }
    {
        LAS float* scr = (LAS float*)(lds + wid * 16384);
        const float* wg = (const float*)a.in[6]; const float* wu = (const float*)a.in[7]; const float* wd = (const float*)a.in[8];
        const float* fin = (const float*)a.in[9]; const float* fout = (const float*)a.in[13];
        const float* din = (const float*)a.in[14]; const float* dout = (const float*)a.in[17];
        const int gw = bid * NWAVES + wid, NGW = G * NWAVES;
        constexpr int I_FFN = 1408, I_FIN = 1536, I_OUT = 512, I_DIN = 4608;
        constexpr int NITEMS = 8 * 3 * I_FFN + 2 * I_FIN + 2 * I_OUT + 2 * I_DIN + 2 * I_OUT;
        for (int it = gw; it < NITEMS; it += NGW) {
            int r = it;
            if (r < 8 * 3 * I_FFN) {
                const int f = r / (3 * I_FFN); r -= f * 3 * I_FFN; const int w3 = r / I_FFN; r -= w3 * I_FFN;
                bf16_t* gu = (bf16_t*)(ws + WS_W + (size_t)f * FFN_BLK);
                if (w3 == 0) conv_item(wg + (size_t)f * DM * FF, DM, FF, FF / 32, gu, 1, scr, r, lane);
                else if (w3 == 1) conv_item(wu + (size_t)f * DM * FF, DM, FF, FF / 32, gu, 2, scr, r, lane);
                else conv_item(wd + (size_t)f * FF * DM, FF, DM, DM / 32, (bf16_t*)(ws + WS_W + (size_t)f * FFN_BLK + FFN_DOWN_OFF), 0, scr, r, lane);
                continue;
            }
            r -= 8 * 3 * I_FFN;
            if (r < 2 * I_FIN) { const int j = r / I_FIN; r -= j * I_FIN; conv_item(fin + (size_t)j * DM * 3088, DM, 3088, 96, (bf16_t*)(ws + WS_FOXIN + (size_t)j * FOXIN_SZ), 3, scr, r, lane); continue; }
            r -= 2 * I_FIN;
            if (r < 2 * I_OUT) { const int j = r / I_OUT; r -= j * I_OUT; conv_item(fout + (size_t)j * DM * DM, DM, DM, 32, (bf16_t*)(ws + WS_FOXOUT + (size_t)j * OUT_SZ), 0, scr, r, lane); continue; }
            r -= 2 * I_OUT;
            if (r < 2 * I_DIN) { const int j = r / I_DIN; r -= j * I_DIN; conv_item(din + (size_t)j * DM * 9216, DM, 9216, 288, (bf16_t*)(ws + WS_DILIN + (size_t)j * DILIN_SZ), 3, scr, r, lane); continue; }
            r -= 2 * I_DIN;
            { const int j = r / I_OUT; r -= j * I_OUT; conv_item(dout + (size_t)j * DM * DM, DM, DM, 32, (bf16_t*)(ws + WS_DILOUT + (size_t)j * OUT_SZ), 0, scr, r, lane); }
        }
    }
}

template <bool FOX>
__device__ __forceinline__ void norm_phase(LAS unsigned char* lds, const float* xin, const float* g, const float* sc1p, const float* shift, bf16_t* hout,
                                           const float* wf_src, const float* bfv, float* cumloc, float* chtot) {
    const int tid = fresh_tid(), lane = tid & 63, wid = __builtin_amdgcn_readfirstlane(tid >> 6);
    const int G = gridDim.x;
    LAS float* wfL = (LAS float*)lds;
    if (FOX) {
        for (int k = tid; k < DM; k += NTHREADS) {
            const float* src = wf_src + (size_t)k * 3088;
#pragma unroll
            for (int q = 0; q < 4; ++q) { const f32x4 v = *(const f32x4*)(src + 4 * q);
#pragma unroll
                for (int e = 0; e < 4; ++e) wfL[(4 * q + e) * DM + k] = v[e]; }
        }
        __syncthreads();
    }
    for (int chunk = blockIdx.x; chunk < MT / 128; chunk += G) {
        const int b = chunk >> 5;
        const int row_base = chunk * 128 + wid * 16;
        f32x4 A[4], Bc[4];
#pragma unroll
        for (int j = 0; j < 4; ++j) {
            const int col = 4 * lane + 256 * j;
            A[j] = *(const f32x4*)(g + col) * *(const f32x4*)(sc1p + (size_t)b * MODN + col);
            Bc[j] = *(const f32x4*)(shift + (size_t)b * MODN + col);
        }
        float run = 0.f;
#pragma unroll 1
        for (int rg = 0; rg < 4; ++rg) {
            f32x4 hv[4][4];
#pragma unroll
            for (int rr = 0; rr < 4; ++rr) {
                const float* xr = xin + (size_t)(row_base + rg * 4 + rr) * DM + 4 * lane;
#pragma unroll
                for (int j = 0; j < 4; ++j) hv[rr][j] = *(const f32x4*)(xr + 256 * j);
            }
#pragma unroll
            for (int rr = 0; rr < 4; ++rr) {
                float ss = 0.f;
#pragma unroll
                for (int j = 0; j < 4; ++j) { const f32x4 t = hv[rr][j] * hv[rr][j]; ss += (t[0] + t[1]) + (t[2] + t[3]); }
                ss = wave_sum(ss);
                const float rstd = 1.0f / sqrtf(ss * (1.0f / DM) + 1e-6f);
                bf16_t* orow = hout + (size_t)(row_base + rg * 4 + rr) * DM + 4 * lane;
#pragma unroll
                for (int j = 0; j < 4; ++j) {
                    hv[rr][j] = hv[rr][j] * rstd * A[j] + Bc[j];
                    u32x2 w; w.x = pk2(hv[rr][j][0], hv[rr][j][1]); w.y = pk2(hv[rr][j][2], hv[rr][j][3]);
                    *(u32x2*)(orow + 256 * j) = w;
                }
            }
            if (FOX) {
                float zs[4] = {0.f, 0.f, 0.f, 0.f};
#pragma unroll 1
                for (int hh = 0; hh < 16; ++hh) {
                    f32x4 wv[4];
#pragma unroll
                    for (int j = 0; j < 4; ++j) wv[j] = *(const LAS f32x4*)(wfL + hh * DM + 4 * lane + 256 * j);
#pragma unroll
                    for (int rr = 0; rr < 4; ++rr) {
                        float s = 0.f;
#pragma unroll
                        for (int j = 0; j < 4; ++j) { const f32x4 t = hv[rr][j] * wv[j]; s += (t[0] + t[1]) + (t[2] + t[3]); }
                        s = wave_sum(s);
                        zs[rr] = ((lane & 15) == hh) ? s : zs[rr];
                    }
                }
                const float bfl = bfv[lane & 15];
                float* cp = cumloc + ((size_t)(b * NH + (lane & 15))) * SEQ + (chunk & 31) * 128 + wid * 16 + rg * 4;
#pragma unroll
                for (int rr = 0; rr < 4; ++rr) {
                    const float z = zs[rr] + bfl;
                    const float ls = -(fmaxf(-z, 0.f) + log1pf(__expf(-fabsf(z))));
                    run += ls;
                    if (lane < 16) cp[rr] = run;
                }
            }
        }
        if (FOX) { if (lane < 16) chtot[(b * NH + lane) * 256 + (chunk & 31) * 8 + wid] = run; }
    }
}

__device__ __forceinline__ void merge_phase(const bf16_t* qkv, const float* lse, bf16_t* hout) {
    const int tid = fresh_tid(), lane = tid & 63, wid = tid >> 6;
    const int gw = blockIdx.x * NWAVES + wid, NGW = gridDim.x * NWAVES;
    const int head = lane >> 2;
    for (int row = gw; row < MT / 2; row += NGW) {
        float ls[3], w[3];
#pragma unroll
        for (int g = 0; g < 3; ++g) ls[g] = lse[((size_t)row * 3 + g) * NH + head];
        const float mx = fmaxf(ls[0], fmaxf(ls[1], ls[2]));
        float sw = 0.f;
#pragma unroll
        for (int g = 0; g < 3; ++g) { w[g] = __builtin_amdgcn_exp2f(ls[g] - mx); sw += w[g]; }
        const float inv = 1.0f / sw;
        float acc[16];
#pragma unroll
        for (int e = 0; e < 16; ++e) acc[e] = 0.f;
#pragma unroll
        for (int g = 0; g < 3; ++g) {
            const u32x4* p = (const u32x4*)(qkv + (size_t)row * 9216 + g * 3072 + 16 * lane);
            const u32x4 v0 = p[0], v1 = p[1]; const float wg = w[g] * inv;
#pragma unroll
            for (int e = 0; e < 4; ++e) { acc[2 * e] += wg * bflo(v0[e]); acc[2 * e + 1] += wg * bfhi(v0[e]); acc[8 + 2 * e] += wg * bflo(v1[e]); acc[8 + 2 * e + 1] += wg * bfhi(v1[e]); }
        }
        u32x4 o0, o1;
#pragma unroll
        for (int e = 0; e < 4; ++e) { o0[e] = pk2(acc[2 * e], acc[2 * e + 1]); o1[e] = pk2(acc[8 + 2 * e], acc[8 + 2 * e + 1]); }
        u32x4* op = (u32x4*)(hout + (size_t)row * DM + 16 * lane);
        op[0] = o0; op[1] = o1;
    }
}

__device__ __forceinline__ void fox_attn_phase(LAS unsigned char* lds, bf16_t* Qb, const bf16_t* Kb, const bf16_t* Vb, const float* cumloc, const float* chtot) {
    const int tid = fresh_tid(), lane = tid & 63;
    const int G = gridDim.x;
    LAS float* cumL = (LAS float*)(lds + att::CUM_OFF);
    LAS float* pfL = (LAS float*)(lds + att::PF_OFF);
    LAS float* wtL = (LAS float*)(lds + att::PF_OFF + 1024);
    for (int i = 0;; ++i) {
        const int id = i * G + blockIdx.x; if (id >= NB * NH * 16) break;
        const int bh = id & 127, jj = id >> 7, qb = jj ^ ((jj >> 1) & 1);
        __syncthreads();
        {
            float v = (tid < 256) ? chtot[bh * 256 + tid] : 0.f; const float own = v;
#pragma unroll
            for (int off = 1; off < 64; off <<= 1) { const float t = __shfl_up(v, off); if (lane >= off) v += t; }
            if (lane == 63 && tid < 256) wtL[tid >> 6] = v;
            __syncthreads();
            float pre = 0.f;
            for (int w = 0; w < (tid >> 6); ++w) pre += (w < 4) ? wtL[w] : 0.f;
            if (tid < 256) pfL[tid] = v - own + pre;
        }
        __syncthreads();
        const int nk = qb * 256 + 256;
        for (int s = tid; s < nk; s += NTHREADS) cumL[s] = -(cumloc[(size_t)bh * SEQ + s] + pfL[s >> 4]) * LOG2E;
        att::Unit U;
        const size_t base = (size_t)(bh >> 4) * SEQ * DM + (size_t)(bh & 15) * 64;
        U.Q = Qb + base; U.K = Kb + base; U.V = Vb + base; U.O = Qb + base; U.stride = DM;
        U.q0 = qb * 256; U.t_lo = 0; U.t_hi = 4 * qb + 4; U.window = 1 << 30; U.bias = 1; U.lse = nullptr; U.lse_stride = 0;
        att::unit_run(lds, U);
    }
}
__device__ __forceinline__ void dil_attn_phase(LAS unsigned char* lds, bf16_t* qkv, float* lse) {
    const int G = gridDim.x;
    for (int i = 0;; ++i) {
        const int id = i * G + blockIdx.x; if (id >= 4 * NH * 48) break;
        const int sub = id & 15, g = (id >> 4) % 3, h = (id / 48) & 15, bl = id / 768;
        int d, rho, blk;
        if (g == 0) { d = 1; rho = 0; blk = sub; } else if (g == 1) { d = 4; rho = sub >> 2; blk = sub & 3; } else { d = 16; rho = sub; blk = 0; }
        __syncthreads();
        att::Unit U;
        const size_t rowl = (size_t)bl * SEQ + rho;
        bf16_t* qp = qkv + rowl * 9216 + (size_t)g * 3072 + h * 64;
        U.Q = qp; U.K = qp + 1024; U.V = qp + 2048; U.O = qp; U.stride = (long)d * 9216;
        U.q0 = blk * 256; U.t_lo = (4 * blk - 2 > 0) ? 4 * blk - 2 : 0; U.t_hi = 4 * blk + 4; U.window = 128; U.bias = 0;
        U.lse = lse + (rowl * 3 + g) * NH + h; U.lse_stride = (long)d * 48;
        att::unit_run(lds, U);
    }
}

#ifndef PMASK
#define PMASK 255
#endif
enum { OP_NORM = 0, OP_GU = 1, OP_DOWN = 2, OP_QKV = 3, OP_ATT = 4, OP_OUT = 5, OP_PROJ = 6, OP_DATT = 7, OP_MERGE = 8 };
constexpr int N_PHASES = 1 + 2 * 10 + 2 * 14;

typedef const Args __attribute__((address_space(4))) CArgs;
__device__ __forceinline__ CArgs& fresh_args() { unsigned long long p = (unsigned long long)__builtin_amdgcn_kernarg_segment_ptr(); asm volatile("" : "+s"(p)); return *(CArgs*)p; }
__device__ __forceinline__ void run_phase(LAS unsigned char* lds, int ph) {
    CArgs& a = fresh_args();
    if (ph == 0) { if (PMASK & 1) prologue_phase(a, lds); return; }
    int p = ph - 1, layer = 0, n;
    for (;;) { n = (layer & 1) ? 14 : 10; if (p < n) break; p -= n; ++layer; }
    const bool dil = (layer & 1) != 0; const int j = layer >> 1;
    int op, sub, hb = 0, ffn = 0;
    if (p < 3) { sub = 0; ffn = 0; op = p; }
    else if (p >= n - 3) { sub = 2; ffn = 1; op = p - (n - 3); }
    else { sub = 1; const int q = p - 3;
        if (!dil) op = (q == 0) ? OP_NORM : (q == 1) ? OP_QKV : (q == 2) ? OP_ATT : OP_OUT;
        else if (q == 0) op = OP_NORM; else if (q == 7) op = OP_OUT; else { hb = (q - 1) / 3; const int r = (q - 1) % 3; op = (r == 0) ? OP_PROJ : (r == 1) ? OP_DATT : OP_MERGE; } }
    unsigned char* ws = a.ws;
    const float* x0 = (const float*)a.in[0];
    float* xo = a.out;
    const bool first = (layer == 0 && sub == 0);
    const float* xin = first ? x0 : (const float*)xo;
    const float* modl = (const float*)(ws + WS_MOD) + (size_t)layer * NB * MODN + (size_t)sub * 3 * DM;
    bf16_t* HB = (bf16_t*)(ws + WS_H);
    bf16_t* BIG = (bf16_t*)(ws + WS_BIG);
    const int G = gridDim.x, bid = blockIdx.x;
    const int f = layer * 2 + ffn;
    if (op == OP_NORM && (PMASK & 2)) {
        const float* g = (const float*)a.in[5] + (size_t)(layer * 3 + sub) * DM;
        if (sub == 1 && !dil)
            norm_phase<true>(lds, xin, g, modl + DM, modl, HB, (const float*)a.in[9] + (size_t)j * DM * 3088 + 3072, (const float*)a.in[10] + j * NH, (float*)(ws + WS_CUM), (float*)(ws + WS_CHT));
        else
            norm_phase<false>(lds, xin, g, modl + DM, modl, HB, nullptr, nullptr, nullptr, nullptr);
    } else if ((op == OP_GU || op == OP_DOWN || op == OP_OUT || op == OP_QKV || op == OP_PROJ) && (PMASK & 4)) {
        pg8::Gemm gm; pg8::StaticOrder S; pg8::EpiAny E;
        E.kind = 0; E.s.Hd = BIG; E.r.xin = xin; E.r.xout = xo; E.r.coef = modl + 2 * DM;
        E.q.out = BIG; E.q.fox = 1; E.q.qg = nullptr; E.q.kg = nullptr; E.q.cs = nullptr; E.q.sn = nullptr;
        if (op == OP_GU) { gm = pg8::Gemm{HB, (const bf16_t*)(ws + WS_W + (size_t)f * FFN_BLK), MT, 2 * FF, DM}; E.kind = 0; }
        else if (op == OP_DOWN) { gm = pg8::Gemm{BIG, (const bf16_t*)(ws + WS_W + (size_t)f * FFN_BLK + FFN_DOWN_OFF), MT, DM, FF}; E.kind = 1; }
        else if (op == OP_OUT) { E.kind = 1;
            if (!dil) gm = pg8::Gemm{BIG, (const bf16_t*)(ws + WS_FOXOUT + (size_t)j * OUT_SZ), MT, DM, DM};
            else gm = pg8::Gemm{HB, (const bf16_t*)(ws + WS_DILOUT + (size_t)j * OUT_SZ), MT, DM, DM}; }
        else if (op == OP_QKV) { E.kind = 2;
            gm = pg8::Gemm{HB, (const bf16_t*)(ws + WS_FOXIN + (size_t)j * FOXIN_SZ), MT, 3072, DM};
            E.q.qg = (const float*)a.in[11] + j * 64; E.q.kg = (const float*)a.in[12] + j * 64; }
        else { E.kind = 2; E.q.fox = 0;
            gm = pg8::Gemm{HB + (size_t)hb * (MT / 2) * DM, (const bf16_t*)(ws + WS_DILIN + (size_t)j * DILIN_SZ), MT / 2, 9216, DM};
            E.q.qg = (const float*)a.in[15] + j * 192; E.q.kg = (const float*)a.in[16] + j * 192;
            E.q.cs = (const float*)(ws + WS_COS) + (size_t)hb * (MT / 2) * 8; E.q.sn = (const float*)(ws + WS_SIN) + (size_t)hb * (MT / 2) * 8; }
        S.init(gm.M, gm.N, G, bid);
        pg8::gemm_phase<pg8::EpiAny, pg8::StaticOrder, true, true>(lds, gm, S, E);
    } else if (op == OP_ATT && (PMASK & 32)) {
        fox_attn_phase(lds, BIG, BIG + (size_t)MT * DM, BIG + (size_t)2 * MT * DM, (const float*)(ws + WS_CUM), (const float*)(ws + WS_CHT));
    } else if (op == OP_DATT && (PMASK & 64)) {
        dil_attn_phase(lds, BIG, (float*)(ws + WS_LSE));
    } else if (op == OP_MERGE && (PMASK & 128)) {
        merge_phase(BIG, (const float*)(ws + WS_LSE), HB + (size_t)hb * (MT / 2) * DM);
    }
}

#ifndef MK_COOP
#define MK_COOP 0
#endif

__global__ void __launch_bounds__(NTHREADS, 2) mk_fwd(Args a) {
    extern __shared__ __attribute__((aligned(16))) unsigned char lds_raw[];
    LAS unsigned char* lds = (LAS unsigned char*)lds_raw;
    const int lo = fresh_args().ph_lo;
    for (int ph = lo;; ++ph) {
        run_phase(lds, ph);
        if (ph + 1 >= fresh_args().ph_hi) break;
        cg::this_grid().sync();
    }
}

extern "C" void kernel_launch(void* const* d_in, const int* in_sizes, int n_in, void* d_out, int out_size, void* d_ws, size_t ws_size, hipStream_t stream) {
    static int grid = 0;
    if (grid == 0) {
        if (n_in != 18 || out_size != MT * DM || ws_size < WS_END) { fprintf(stderr, "kernel_launch: unexpected shapes (n_in %d, out %d, ws %zu; need ws >= %zu)\n", n_in, out_size, ws_size, (size_t)WS_END); grid = -1; return; }
        int dev = 0, cus = 0, per_cu = 0;
        if (hipGetDevice(&dev) != hipSuccess || hipDeviceGetAttribute(&cus, hipDeviceAttributeMultiprocessorCount, dev) != hipSuccess) { grid = -1; return; }
        if (hipFuncSetAttribute((const void*)mk_fwd, hipFuncAttributeMaxDynamicSharedMemorySize, LDS_BYTES) != hipSuccess) { fprintf(stderr, "kernel_launch: hipFuncSetAttribute failed\n"); grid = -1; return; }
        if (hipOccupancyMaxActiveBlocksPerMultiprocessor(&per_cu, (const void*)mk_fwd, NTHREADS, LDS_BYTES) != hipSuccess || per_cu < 1) { per_cu = 1; (void)hipGetLastError(); }
        grid = cus * per_cu;
    }
    if (grid < 0) return;
    Args a{};
    for (int i = 0; i < 18; ++i) a.in[i] = d_in[i];
    a.out = (float*)d_out; a.ws = (unsigned char*)d_ws;
#if MK_COOP
    a.ph_lo = 0; a.ph_hi = N_PHASES;
    void* args[] = {&a};
    hipError_t e = hipLaunchCooperativeKernel((const void*)mk_fwd, dim3(grid), dim3(NTHREADS), args, LDS_BYTES, stream);
    if (e != hipSuccess) fprintf(stderr, "cooperative launch failed: %s (grid %d)\n", hipGetErrorString(e), grid);
#else
    for (int ph = 0; ph < N_PHASES; ++ph) {
        a.ph_lo = ph; a.ph_hi = ph + 1;
        hipLaunchKernelGGL(mk_fwd, dim3(grid), dim3(NTHREADS), LDS_BYTES, stream, a);
    }
#endif
}
```

```cpp
#include <hip/hip_runtime.h>
#include <hip/hip_cooperative_groups.h>
#include <cstdio>
#include <cstdint>
#include <cmath>
namespace cg = cooperative_groups;
namespace pg8 {
#define PG8_LAS __attribute__((address_space(3)))
typedef unsigned short bf16_t;
typedef short bf16x8 __attribute__((ext_vector_type(8)));
typedef float f32x4 __attribute__((ext_vector_type(4)));
typedef unsigned u32x4 __attribute__((ext_vector_type(4)));
constexpr int BM = 256, BK = 64, HALF = 128, HTB = HALF * BK * 2  , STAGE_BYTES = 8 * HTB, NXCD = 8, WGM = 8;

__host__ __device__ __forceinline__ int lds_byte(int r, int c) { const int st = (r >> 4) * 2 + (c >> 5), rr = r & 15, cc = c & 31, ob = rr * 64 + cc * 2; return st * 1024 + (ob ^ (((ob >> 9) & 1) << 5)); }
__host__ __device__ __forceinline__ void stage_rc(int b, int& R, int& C) { const int st = b / 1024, sb = b % 1024, swz = sb ^ (((sb >> 9) & 1) << 5); R = (st >> 1) * 16 + swz / 64; C = (st & 1) * 32 + (swz % 64) / 2; }
__host__ __device__ __forceinline__ int perm32(int rho) { const int n = rho >> 4, i = rho & 15; return 8 * (i >> 2) + 4 * n + (i & 3); }

struct Unit { int pm, pn; };
struct Gemm { const bf16_t* A; const bf16_t* Bt; int M, N, K; };

struct StaticOrder {
    int nM, nN, nwg, G, c;
    __host__ __device__ void init(int M, int N, int G_, int c_) { nM = M / BM; nN = N / BM; nwg = nM * nN; G = G_; c = c_; }
    __host__ __device__ bool next(int i, Unit& u) const {
        const long L = (long)i * G + c; if (L >= nwg) return false;
        int wgid = (int)L; { const int q = nwg / NXCD, r = nwg % NXCD, xcd = wgid % NXCD, off = wgid / NXCD; wgid = (xcd < r ? xcd * (q + 1) : r * (q + 1) + (xcd - r) * q) + off; }
        const int nig = WGM * nN, gid = wgid / nig, fm = gid * WGM, gsz = (nM - fm) < WGM ? (nM - fm) : WGM;
        u.pm = fm + ((wgid % nig) % gsz); u.pn = (wgid % nig) / gsz; return true;
    }
    __device__ __forceinline__ void a_ready(const Unit&) const {}
    __device__ __forceinline__ void done(const Unit&) const {}
};

__device__ __forceinline__ unsigned cvt_pk_bf16(float lo, float hi) { unsigned r; asm volatile("v_cvt_pk_bf16_f32 %0, %1, %2" : "=v"(r) : "v"(lo), "v"(hi)); return r; }
typedef float f32x2 __attribute__((ext_vector_type(2)));
constexpr int P_MT = 32768, P_DM = 1024, P_FF = 2816, P_MODN = 9216;
constexpr float P_C2 = 0.125f * 1.4426950408889634f;

struct EpiSwiGLU {
    static constexpr bool PERM = true, AFTER_DRAIN = false;
    bf16_t* Hd;
    __device__ __forceinline__ void operator()(const f32x4 (&acc)[2][2][4][2], const Unit& u, int wr, int wc, int fr, int fq) const {
        const int row0 = u.pm * BM + wr * 64 + fr, col0 = u.pn * 128 + wc * 32 + 8 * fq;
#pragma unroll
        for (int ai = 0; ai < 2; ++ai)
#pragma unroll
            for (int m = 0; m < 4; ++m) {
                bf16_t* rowp = Hd + (size_t)(row0 + ai * HALF + m * 16) * P_FF + col0;
                float v[8];
#pragma unroll
                for (int n = 0; n < 2; ++n)
#pragma unroll
                    for (int e = 0; e < 4; ++e) {
                        const float g = acc[ai][0][m][n][e], up = acc[ai][1][m][n][e];
                        const float s = __builtin_amdgcn_rcpf(1.0f + __builtin_amdgcn_exp2f(-1.4426950408889634f * g));
                        v[n * 4 + e] = g * s * up;
                    }
                u32x4 w; w.x = cvt_pk_bf16(v[0], v[1]); w.y = cvt_pk_bf16(v[2], v[3]); w.z = cvt_pk_bf16(v[4], v[5]); w.w = cvt_pk_bf16(v[6], v[7]);
                *(u32x4*)rowp = w;
            }
    }
};

struct EpiResid {
    static constexpr bool PERM = true, AFTER_DRAIN = false;
    const float* xin; float* xout; const float* coef;
    __device__ __forceinline__ void operator()(const f32x4 (&acc)[2][2][4][2], const Unit& u, int wr, int wc, int fr, int fq) const {
        const int row0 = u.pm * BM + wr * 64 + fr, col0 = u.pn * BM + wc * 32 + 8 * fq;
        const float* cf = coef + (size_t)(u.pm >> 4) * P_MODN + col0;
        f32x4 cv[2][2];
#pragma unroll
        for (int bj = 0; bj < 2; ++bj)
#pragma unroll
            for (int n = 0; n < 2; ++n) cv[bj][n] = *(const f32x4*)(cf + bj * HALF + n * 4);
#pragma unroll
        for (int ai = 0; ai < 2; ++ai)
#pragma unroll
            for (int m = 0; m < 4; ++m) {
                const size_t off = (size_t)(row0 + ai * HALF + m * 16) * P_DM + col0;
#pragma unroll
                for (int bj = 0; bj < 2; ++bj)
#pragma unroll
                    for (int n = 0; n < 2; ++n) {
                        const f32x4 xi = *(const f32x4*)(xin + off + bj * HALF + n * 4);
                        *(f32x4*)(xout + off + bj * HALF + n * 4) = xi + cv[bj][n] * acc[ai][bj][m][n];
                    }
            }
    }
};

struct EpiQKV {
    static constexpr bool PERM = true, AFTER_DRAIN = false;
    bf16_t* out; int fox; const float* qg; const float* kg; const float* cs; const float* sn;
    __device__ __forceinline__ void operator()(const f32x4 (&acc)[2][2][4][2], const Unit& u, int wr, int wc, int fr, int fq) const {
        int which, colbase, pitch; bf16_t* base; const float* gq; const float* gk;
        if (fox) { which = u.pn >> 2; base = out + (size_t)which * ((size_t)P_MT * P_DM); pitch = P_DM; colbase = (u.pn & 3) * 256; gq = qg; gk = kg; }
        else { const int grp = u.pn / 12; which = (u.pn % 12) >> 2; base = out; pitch = 9216; colbase = u.pn * 256; gq = qg + grp * 64; gk = kg + grp * 64; }
        const int row0 = u.pm * BM + wr * 64 + fr;
        const int cw = colbase + wc * 64 + 8 * fq;
        if (which == 2) {
#pragma unroll
            for (int ai = 0; ai < 2; ++ai)
#pragma unroll
                for (int m = 0; m < 4; ++m) {
                    bf16_t* rowp = base + (size_t)(row0 + ai * HALF + m * 16) * pitch + cw;
#pragma unroll
                    for (int bj = 0; bj < 2; ++bj) {
                        const f32x4 v0 = acc[ai][bj][m][0], v1 = acc[ai][bj][m][1];
                        u32x4 w; w.x = cvt_pk_bf16(v0[0], v0[1]); w.y = cvt_pk_bf16(v0[2], v0[3]); w.z = cvt_pk_bf16(v1[0], v1[1]); w.w = cvt_pk_bf16(v1[2], v1[3]);
                        *(u32x4*)(rowp + bj * 32) = w;
                    }
                }
        } else {
            const float* gp = (which == 0) ? gq : gk; const float osc = (which == 0) ? P_C2 : 1.0f;
            f32x4 gv[2][2];
#pragma unroll
            for (int bj = 0; bj < 2; ++bj)
#pragma unroll
                for (int n = 0; n < 2; ++n) gv[bj][n] = *(const f32x4*)(gp + 32 * bj + 8 * fq + 4 * n) * osc;
#pragma unroll
            for (int ai = 0; ai < 2; ++ai)
#pragma unroll
                for (int m = 0; m < 4; ++m) {
                    const int row = row0 + ai * HALF + m * 16;
                    f32x4 v[2][2]; float ss = 0.f;
#pragma unroll
                    for (int bj = 0; bj < 2; ++bj)
#pragma unroll
                        for (int n = 0; n < 2; ++n) { v[bj][n] = acc[ai][bj][m][n]; const f32x4 t = v[bj][n] * v[bj][n]; ss += (t[0] + t[1]) + (t[2] + t[3]); }
                    ss += __shfl_xor(ss, 16); ss += __shfl_xor(ss, 32);
                    const float rstd = 1.0f / sqrtf(ss * (1.0f / 64.0f) + 1e-6f);
#pragma unroll
                    for (int bj = 0; bj < 2; ++bj)
#pragma unroll
                        for (int n = 0; n < 2; ++n) v[bj][n] = v[bj][n] * rstd * gv[bj][n];
                    if (!fox) {
#pragma unroll
                        for (int n = 0; n < 2; ++n) {
                            const f32x4 c = *(const f32x4*)(cs + (size_t)row * 8 + 4 * n), s = *(const f32x4*)(sn + (size_t)row * 8 + 4 * n);
                            f32x4 oth;
#pragma unroll
                            for (int e = 0; e < 4; ++e) oth[e] = __shfl_xor(v[0][n][e], 16);
                            const f32x4 r0 = v[0][n] * c - oth * s, r1 = v[0][n] * c + oth * s;
                            v[0][n] = (fq == 0) ? r0 : ((fq == 1) ? r1 : v[0][n]);
                        }
                    }
                    bf16_t* rowp = base + (size_t)row * pitch + cw;
#pragma unroll
                    for (int bj = 0; bj < 2; ++bj) {
                        const f32x4 v0 = v[bj][0], v1 = v[bj][1];
                        u32x4 w; w.x = cvt_pk_bf16(v0[0], v0[1]); w.y = cvt_pk_bf16(v0[2], v0[3]); w.z = cvt_pk_bf16(v1[0], v1[1]); w.w = cvt_pk_bf16(v1[2], v1[3]);
                        *(u32x4*)(rowp + bj * 32) = w;
                    }
                }
        }
    }
};

struct EpiAny {
    static constexpr bool PERM = true, AFTER_DRAIN = false;
    int kind; EpiSwiGLU s; EpiResid r; EpiQKV q;
    __device__ __forceinline__ void operator()(const f32x4 (&acc)[2][2][4][2], const Unit& u, int wr, int wc, int fr, int fq) const {
        if (kind == 0) s(acc, u, wr, wc, fr, fq); else if (kind == 1) r(acc, u, wr, wc, fr, fq); else q(acc, u, wr, wc, fr, fq);
    }
};
template <class Epi, class Sched, bool ALIGN_EPI = false, bool SP2 = false>
__device__ __forceinline__ void gemm_phase(PG8_LAS unsigned char* lds, const Gemm g, const Sched& S, const Epi& E) {
    int tid_ = threadIdx.x; asm volatile("" : "+v"(tid_)); const int tid = tid_, wid = __builtin_amdgcn_readfirstlane(tid >> 6), lane = tid & 63, wr = wid >> 2, wc = wid & 3, fr = lane & 15, fq = lane >> 4;
    const int K = g.K, nt = K / BK;
    unsigned voffA[2], voffB[2];
#pragma unroll
    for (int i = 0; i < 2; ++i) { int R, C; stage_rc(tid * 16 + i * 8192, R, C); const int Rb = Epi::PERM ? ((R & ~31) + perm32(R & 31)) : R;
        voffA[i] = (unsigned)(R * K + C) * 2u; voffB[i] = (unsigned)(Rb * K + C) * 2u; }
    const size_t kstep = (size_t)(BK * 2);
    const size_t hstep = (size_t)HALF * K * 2;
    const size_t tstep = 2 * hstep;
    const unsigned ldsw = (unsigned)wid * 1024u;
    const int aoff = lds_byte(wr * 64 + fr, fq * 8), boff = lds_byte(wc * 32 + fr, fq * 8);
#define PG8_SA(b, h) (((b) * 2 + (h)) * HTB)
#define PG8_SB(b, h) ((4 + (b) * 2 + (h)) * HTB)
#define PG8_STAGE(bufoff, gbase, voff) do { _Pragma("unroll") for (int _i = 0; _i < 2; ++_i) \
        __builtin_amdgcn_global_load_lds((const unsigned*)((const char*)(gbase) + (voff)[_i]), (PG8_LAS unsigned*)(lds + (bufoff) + ldsw + _i * 8192), 16, 0, 0); } while (0)
#define PG8_LDA(dst, b, h) do { _Pragma("unroll") for (int m = 0; m < 4; ++m) _Pragma("unroll") for (int k = 0; k < 2; ++k) dst[m][k] = *(const PG8_LAS bf16x8*)(lds + PG8_SA(b, h) + aoff + m * 2048 + k * 1024); } while (0)
#define PG8_LDB(dst, b, h) do { _Pragma("unroll") for (int n = 0; n < 2; ++n) _Pragma("unroll") for (int k = 0; k < 2; ++k) dst[n][k] = *(const PG8_LAS bf16x8*)(lds + PG8_SB(b, h) + boff + n * 2048 + k * 1024); } while (0)
#define PG8_MMA(ai, bj, At, Bt) do { __builtin_amdgcn_s_setprio(1); _Pragma("unroll") for (int m = 0; m < 4; ++m) _Pragma("unroll") for (int n = 0; n < 2; ++n) _Pragma("unroll") for (int k = 0; k < 2; ++k) \
        acc[ai][bj][m][n] = __builtin_amdgcn_mfma_f32_16x16x32_bf16(Bt[n][k], At[m][k], acc[ai][bj][m][n], 0, 0, 0); __builtin_amdgcn_s_setprio(0); } while (0)
#define PG8_WAIT_V(n) asm volatile("s_waitcnt vmcnt(" #n ")" ::: "memory")
#define PG8_WAIT_L(n) asm volatile("s_waitcnt lgkmcnt(" #n ")" ::: "memory")
#define PG8_BAR __builtin_amdgcn_s_barrier()
#define PG8_SCHED __builtin_amdgcn_sched_barrier(0)
    Unit cur, nxt; int ui = 0;
    if (!S.next(0, cur)) return;
    f32x4 acc[2][2][4][2];
#pragma unroll
    for (int a = 0; a < 2; ++a)
#pragma unroll
        for (int b = 0; b < 2; ++b)
#pragma unroll
            for (int m = 0; m < 4; ++m)
#pragma unroll
                for (int n = 0; n < 2; ++n) acc[a][b][m][n] = (f32x4){0.f, 0.f, 0.f, 0.f};
    bf16x8 At[4][2], B0[2][2], B1[2][2];
    const char* cA = (const char*)g.A + (size_t)cur.pm * tstep; const char* cB = (const char*)g.Bt + (size_t)cur.pn * tstep;
    S.a_ready(cur);
    if constexpr (SP2) {
        PG8_STAGE(PG8_SB(0, 0), cB, voffB); PG8_STAGE(PG8_SB(0, 1), cB + hstep, voffB); PG8_STAGE(PG8_SA(0, 0), cA, voffA); PG8_STAGE(PG8_SA(0, 1), cA + hstep, voffA);
        if (wr == 1) PG8_BAR;
        PG8_WAIT_V(2); PG8_BAR;
        PG8_STAGE(PG8_SB(1, 0), cB + kstep, voffB); PG8_STAGE(PG8_SA(1, 0), cA + kstep, voffA); PG8_STAGE(PG8_SB(1, 1), cB + hstep + kstep, voffB);
        PG8_WAIT_V(6); PG8_BAR;
    } else {
        PG8_STAGE(PG8_SB(0, 0), cB, voffB); PG8_STAGE(PG8_SA(0, 0), cA, voffA); PG8_STAGE(PG8_SB(0, 1), cB + hstep, voffB); PG8_STAGE(PG8_SA(0, 1), cA + hstep, voffA);
        if (wr == 1) PG8_BAR;
        PG8_WAIT_V(4); PG8_BAR;
        PG8_STAGE(PG8_SB(1, 0), cB + kstep, voffB); PG8_STAGE(PG8_SA(1, 0), cA + kstep, voffA); PG8_STAGE(PG8_SB(1, 1), cB + hstep + kstep, voffB);
        PG8_WAIT_V(6); PG8_BAR;
    }
    for (;;) {
        const bool has_next = S.next(ui + 1, nxt);
        const char* nA = has_next ? (const char*)g.A + (size_t)nxt.pm * tstep : cA; const char* nB = has_next ? (const char*)g.Bt + (size_t)nxt.pn * tstep : cB;
        for (int t = 0; t < nt; t += 2) {
            const bool last = (t == nt - 2);
            const char* a1 = cA + (size_t)(t + 1) * kstep;
            const char* a2 = last ? nA : cA + (size_t)(t + 2) * kstep; const char* b2 = last ? nB : cB + (size_t)(t + 2) * kstep;
            const char* a3 = a2 + kstep; const char* b3 = b2 + kstep;
            if (last && has_next) S.a_ready(nxt);
            if constexpr (SP2) {
            PG8_LDB(B0, 0, 0); PG8_LDB(B1, 0, 1); PG8_SCHED; PG8_LDA(At, 0, 0); PG8_STAGE(PG8_SA(1, 1), a1 + hstep, voffA);
            PG8_WAIT_V(8); PG8_WAIT_L(0); PG8_BAR; PG8_MMA(0, 0, At, B0); PG8_MMA(0, 1, At, B1); PG8_BAR; PG8_SCHED;
            PG8_LDA(At, 0, 1); PG8_STAGE(PG8_SB(0, 0), b2, voffB); PG8_STAGE(PG8_SB(0, 1), b2 + hstep, voffB); PG8_STAGE(PG8_SA(0, 0), a2, voffA);
            PG8_WAIT_V(8); PG8_WAIT_L(0); PG8_BAR; PG8_MMA(1, 0, At, B0); PG8_MMA(1, 1, At, B1); PG8_BAR; PG8_SCHED;
            PG8_LDB(B0, 1, 0); PG8_LDB(B1, 1, 1); PG8_SCHED; PG8_LDA(At, 1, 0); PG8_STAGE(PG8_SA(0, 1), a2 + hstep, voffA);
            PG8_WAIT_V(8); PG8_WAIT_L(0); PG8_BAR; PG8_MMA(0, 0, At, B0); PG8_MMA(0, 1, At, B1); PG8_BAR; PG8_SCHED;
            PG8_LDA(At, 1, 1); PG8_STAGE(PG8_SB(1, 0), b3, voffB); PG8_STAGE(PG8_SB(1, 1), b3 + hstep, voffB); PG8_STAGE(PG8_SA(1, 0), a3, voffA);
            PG8_WAIT_V(8); PG8_WAIT_L(0); PG8_BAR; PG8_MMA(1, 0, At, B0); PG8_MMA(1, 1, At, B1); PG8_BAR; PG8_SCHED;
            } else {
            PG8_LDB(B0, 0, 0); PG8_SCHED; PG8_LDA(At, 0, 0); PG8_STAGE(PG8_SA(1, 1), a1 + hstep, voffA);
            PG8_WAIT_L(8); PG8_BAR; PG8_WAIT_L(0); PG8_MMA(0, 0, At, B0); PG8_BAR; PG8_SCHED;
            PG8_LDB(B1, 0, 1); PG8_STAGE(PG8_SB(0, 0), b2, voffB);
            PG8_BAR; PG8_WAIT_L(0); PG8_MMA(0, 1, At, B1); PG8_BAR;
            PG8_LDA(At, 0, 1); PG8_STAGE(PG8_SA(0, 0), a2, voffA);
            PG8_BAR; PG8_WAIT_L(0); PG8_MMA(1, 0, At, B0); PG8_BAR; PG8_SCHED;
            PG8_STAGE(PG8_SB(0, 1), b2 + hstep, voffB);
            PG8_WAIT_V(6); PG8_BAR; PG8_MMA(1, 1, At, B1); PG8_BAR;
            PG8_LDB(B0, 1, 0); PG8_SCHED; PG8_LDA(At, 1, 0); PG8_STAGE(PG8_SA(0, 1), a2 + hstep, voffA);
            PG8_WAIT_L(8); PG8_BAR; PG8_WAIT_L(0); PG8_MMA(0, 0, At, B0); PG8_BAR; PG8_SCHED;
            PG8_LDB(B1, 1, 1); PG8_STAGE(PG8_SB(1, 0), b3, voffB);
            PG8_BAR; PG8_WAIT_L(0); PG8_MMA(0, 1, At, B1); PG8_BAR;
            PG8_LDA(At, 1, 1); PG8_STAGE(PG8_SA(1, 0), a3, voffA);
            PG8_BAR; PG8_WAIT_L(0); PG8_MMA(1, 0, At, B0); PG8_BAR; PG8_SCHED;
            PG8_STAGE(PG8_SB(1, 1), b3 + hstep, voffB);
            PG8_WAIT_V(6); PG8_BAR; PG8_MMA(1, 1, At, B1); PG8_BAR;
            }
        }
        if constexpr (ALIGN_EPI) { if (wr == 0) PG8_BAR; }
        if constexpr (!Epi::AFTER_DRAIN) { E(acc, cur, wr, wc, fr, fq); S.done(cur); }
        if (!has_next) break;
#pragma unroll
        for (int a = 0; a < 2; ++a)
#pragma unroll
            for (int b = 0; b < 2; ++b)
#pragma unroll
                for (int m = 0; m < 4; ++m)
#pragma unroll
                    for (int n = 0; n < 2; ++n) acc[a][b][m][n] = (f32x4){0.f, 0.f, 0.f, 0.f};
        cur = nxt; cA = nA; cB = nB; ++ui;
        if constexpr (ALIGN_EPI) { if (wr == 1) PG8_BAR; }
    }
    PG8_WAIT_V(0);
    if constexpr (!ALIGN_EPI) { if (wr == 0) PG8_BAR; }
    PG8_BAR;
    if constexpr (Epi::AFTER_DRAIN) { E.fused(acc, cur, wr, wc, fr, fq, lds, wid, lane); S.done(cur); }
#undef PG8_SA
#undef PG8_SB
#undef PG8_STAGE
#undef PG8_LDA
#undef PG8_LDB
#undef PG8_MMA
#undef PG8_WAIT_V
#undef PG8_WAIT_L
#undef PG8_BAR
#undef PG8_SCHED
}
}
namespace att {
#define LAS __attribute__((address_space(3)))
typedef unsigned short bf16_t;
typedef short bf16x8 __attribute__((ext_vector_type(8)));
typedef short s16x4 __attribute__((ext_vector_type(4)));
typedef short v4i16_t __attribute__((ext_vector_type(4)));
typedef float f32x4 __attribute__((ext_vector_type(4)));
typedef float f32x16 __attribute__((ext_vector_type(16)));
typedef unsigned u32x4 __attribute__((ext_vector_type(4)));
constexpr int KOFF = 0, VOFF = 16384, CUM_OFF = 32768, WSF_OFF = 49152, PF_OFF = 51200;
constexpr float LOG2E = 1.4426950408889634f;
__device__ __forceinline__ int crow(int r, int hi) { return (r & 3) + 8 * (r >> 2) + 4 * hi; }
__device__ __forceinline__ unsigned cvtpk(float lo, float hi) { unsigned r; asm volatile("v_cvt_pk_bf16_f32 %0, %1, %2" : "=v"(r) : "v"(lo), "v"(hi)); return r; }
__device__ __forceinline__ s16x4 vtr(const LAS unsigned char* p) { return __builtin_bit_cast(s16x4, __builtin_amdgcn_ds_read_tr16_b64_v4i16((LAS v4i16_t*)p)); }

struct Unit {
    const bf16_t* Q; const bf16_t* K; const bf16_t* V; bf16_t* O;
    long stride;
    int q0, t_lo, t_hi, window;
    int bias;
    float* lse; long lse_stride;
};

__device__ __forceinline__ void unit_run(LAS unsigned char* lds, const Unit& U) {
    int tid_ = threadIdx.x; asm volatile("" : "+v"(tid_)); const int tid = tid_, lane = tid & 63, r32 = lane & 31, hi = lane >> 5;
    const int wid = __builtin_amdgcn_readfirstlane(tid >> 6);
    const int srow = tid >> 3, sch = tid & 7;
    const bf16_t* kg = U.K + (long)srow * U.stride + sch * 8;
    const bf16_t* vg = U.V + (long)srow * U.stride + sch * 8;
    const int kst = KOFF + sch * 1024 + srow * 16;
    const int vst = VOFF + (sch >> 2) * 4096 + srow * 64 + (sch & 3) * 16;
    const int uq = U.q0 + wid * 32 + r32;
    bf16x8 qr[4];
#pragma unroll
    for (int d0 = 0; d0 < 4; ++d0) qr[d0] = *(const bf16x8*)(U.Q + (long)uq * U.stride + d0 * 16 + hi * 8);
    float m = -1e30f, l = 0.f;
    f32x16 o0, o1;
#pragma unroll
    for (int r = 0; r < 16; ++r) { o0[r] = 0.f; o1[r] = 0.f; }
    LAS float* wsf = (LAS float*)(lds + WSF_OFF) + wid * 64;
    const LAS float* cumL = (const LAS float*)(lds + CUM_OFF);
    const int wq_lo = U.q0 + wid * 32, wq_hi = wq_lo + 31;
    u32x4 kreg, vreg;
    {
        const long go = (long)U.t_lo * 64 * U.stride;
        kreg = *(const u32x4*)(kg + go); vreg = *(const u32x4*)(vg + go);
        *(LAS u32x4*)(lds + kst) = kreg; *(LAS u32x4*)(lds + vst) = vreg;
    }
    const LAS unsigned char* vp0 = lds + VOFF + ((lane >> 4) & 1) * 32 + (lane & 3) * 8 + (4 * hi + ((lane & 15) >> 2)) * 64;
    const LAS unsigned char* kp0 = lds + KOFF + hi * 1024 + r32 * 16;
    for (int t = U.t_lo; t < U.t_hi; ++t) {
        const int cur = (t - U.t_lo) & 1;
        const bool more = (t + 1 < U.t_hi);
        if (more) { const long go = (long)(t + 1) * 64 * U.stride; kreg = *(const u32x4*)(kg + go); vreg = *(const u32x4*)(vg + go); }
        __syncthreads();
        const bool need = (64 * t <= wq_hi) && (64 * t + 63 >= wq_lo - U.window);
        if (need) {
            const LAS unsigned char* kb = kp0 + cur * 8192;
            f32x16 p0, p1;
#pragma unroll
            for (int r = 0; r < 16; ++r) { p0[r] = 0.f; p1[r] = 0.f; }
#pragma unroll
            for (int d0 = 0; d0 < 4; ++d0) {
                const bf16x8 b0 = *(const LAS bf16x8*)(kb + d0 * 2048), b1 = *(const LAS bf16x8*)(kb + d0 * 2048 + 512);
                p0 = __builtin_amdgcn_mfma_f32_32x32x16_bf16(b0, qr[d0], p0, 0, 0, 0);
                p1 = __builtin_amdgcn_mfma_f32_32x32x16_bf16(b1, qr[d0], p1, 0, 0, 0);
            }
            if (U.bias) {
#pragma unroll
                for (int g = 0; g < 4; ++g) {
                    const f32x4 c0 = *(const LAS f32x4*)(cumL + 64 * t + 8 * g + 4 * hi), c1 = *(const LAS f32x4*)(cumL + 64 * t + 32 + 8 * g + 4 * hi);
#pragma unroll
                    for (int e = 0; e < 4; ++e) { p0[4 * g + e] += c0[e]; p1[4 * g + e] += c1[e]; }
                }
            }
            const bool need_mask = (64 * t + 63 > wq_lo) || (64 * t < wq_hi - U.window);
            if (need_mask) {
                const int lo_ok = uq - U.window;
#pragma unroll
                for (int r = 0; r < 16; ++r) {
                    const int kv = 64 * t + crow(r, hi);
                    if (kv > uq || kv < lo_ok) p0[r] = -INFINITY;
                    if (kv + 32 > uq || kv + 32 < lo_ok) p1[r] = -INFINITY;
                }
            }
            float mx = fmaxf(p0[0], p1[0]);
#pragma unroll
            for (int r = 1; r < 16; ++r) mx = fmaxf(mx, fmaxf(p0[r], p1[r]));
            mx = fmaxf(mx, __shfl_xor(mx, 32));
            const float mn = fmaxf(m, mx);
            const float alpha = __builtin_amdgcn_exp2f(m - mn);
            m = mn;
            float rs = 0.f;
#pragma unroll
            for (int r = 0; r < 16; ++r) { p0[r] = __builtin_amdgcn_exp2f(p0[r] - mn); p1[r] = __builtin_amdgcn_exp2f(p1[r] - mn); rs += p0[r] + p1[r]; }
            l = l * alpha + rs;
            if (hi == 0) wsf[r32] = alpha;
#pragma unroll
            for (int g = 0; g < 4; ++g) {
                const f32x4 a = *(const LAS f32x4*)(wsf + 8 * g + 4 * hi);
#pragma unroll
                for (int e = 0; e < 4; ++e) { o0[4 * g + e] *= a[e]; o1[4 * g + e] *= a[e]; }
            }
            u32x4 pw[4];
#pragma unroll
            for (int c = 0; c < 4; ++c) {
                pw[0][c] = cvtpk(p0[2 * c], p0[2 * c + 1]); pw[1][c] = cvtpk(p0[8 + 2 * c], p0[8 + 2 * c + 1]);
                pw[2][c] = cvtpk(p1[2 * c], p1[2 * c + 1]); pw[3][c] = cvtpk(p1[8 + 2 * c], p1[8 + 2 * c + 1]);
            }
            const LAS unsigned char* vp = vp0 + cur * 8192;
#pragma unroll
            for (int ks = 0; ks < 4; ++ks) {
                const s16x4 a0 = vtr(vp + ks * 1024), a1 = vtr(vp + ks * 1024 + 512), c0 = vtr(vp + 4096 + ks * 1024), c1 = vtr(vp + 4096 + ks * 1024 + 512);
                const bf16x8 pa = __builtin_bit_cast(bf16x8, pw[ks]);
                const bf16x8 v0 = (bf16x8){a0[0], a0[1], a0[2], a0[3], a1[0], a1[1], a1[2], a1[3]};
                const bf16x8 v1 = (bf16x8){c0[0], c0[1], c0[2], c0[3], c1[0], c1[1], c1[2], c1[3]};
                o0 = __builtin_amdgcn_mfma_f32_32x32x16_bf16(pa, v0, o0, 0, 0, 0);
                o1 = __builtin_amdgcn_mfma_f32_32x32x16_bf16(pa, v1, o1, 0, 0, 0);
            }
        }
        if (more) { *(LAS u32x4*)(lds + kst + (cur ^ 1) * 8192) = kreg; *(LAS u32x4*)(lds + vst + (cur ^ 1) * 8192) = vreg; }
    }
    l += __shfl_xor(l, 32);
    if (hi == 0) { wsf[32 + r32] = l; if (U.lse) U.lse[(long)uq * U.lse_stride] = m + __builtin_amdgcn_logf(l); }
    bf16_t* Ow = U.O + (long)(U.q0 + wid * 32) * U.stride;
#pragma unroll
    for (int g = 0; g < 4; ++g) {
        const f32x4 lv = *(const LAS f32x4*)(wsf + 32 + 8 * g + 4 * hi);
#pragma unroll
        for (int e = 0; e < 4; ++e) {
            const int r = 4 * g + e; const float rl = 1.0f / lv[e];
            bf16_t* op = Ow + (long)crow(r, hi) * U.stride + r32;
            const unsigned w0 = cvtpk(o0[r] * rl, 0.f), w1 = cvtpk(o1[r] * rl, 0.f);
            op[0] = (bf16_t)(w0 & 0xffffu); op[32] = (bf16_t)(w1 & 0xffffu);
        }
    }
}
#undef LAS
}
#define LAS __attribute__((address_space(3)))
typedef unsigned short bf16_t;
typedef float f32x4 __attribute__((ext_vector_type(4)));
typedef unsigned u32x4 __attribute__((ext_vector_type(4)));
typedef unsigned u32x2 __attribute__((ext_vector_type(2)));

constexpr int NB = 8, SEQ = 4096, DM = 1024, MT = NB * SEQ, FF = 2816, NH = 16, MODN = 9216;
constexpr int NTHREADS = 512, NWAVES = 8;
constexpr float LOG2E = 1.4426950408889634f;
constexpr size_t MiB = (size_t)1 << 20;
constexpr size_t WS_MOD = 1 * MiB, WS_COS = 3 * MiB, WS_SIN = 4 * MiB, WS_CUM = 5 * MiB, WS_CHT = 7 * MiB, WS_LSE = 8 * MiB;
constexpr size_t WS_W = 16 * MiB, FFN_BLK = (size_t)(2 * FF * DM + DM * FF) * 2, FFN_DOWN_OFF = (size_t)2 * FF * DM * 2;
constexpr size_t WS_FOXIN = WS_W + 8 * FFN_BLK, FOXIN_SZ = (size_t)3072 * DM * 2;
constexpr size_t WS_FOXOUT = WS_FOXIN + 2 * FOXIN_SZ, OUT_SZ = (size_t)DM * DM * 2;
constexpr size_t WS_DILIN = WS_FOXOUT + 2 * OUT_SZ, DILIN_SZ = (size_t)9216 * DM * 2;
constexpr size_t WS_DILOUT = WS_DILIN + 2 * DILIN_SZ;
constexpr size_t WS_H = WS_DILOUT + 2 * OUT_SZ;
constexpr size_t WS_BIG = WS_H + (size_t)MT * DM * 2;
constexpr size_t WS_END = WS_BIG + (size_t)(MT / 2) * 9216 * 2;
static_assert(WS_W + 8 * FFN_BLK == 148 * MiB && WS_H == 204 * MiB && WS_END == 556 * MiB, "workspace map");
constexpr int LDS_BYTES = 147456;

__device__ __forceinline__ unsigned f2bf(float f) { unsigned u = __builtin_bit_cast(unsigned, f); return (u + 0x7fffu + ((u >> 16) & 1u)) >> 16; }
__device__ __forceinline__ unsigned pk2(float lo, float hi) { return f2bf(lo) | (f2bf(hi) << 16); }
__device__ __forceinline__ float bflo(unsigned w) { return __builtin_bit_cast(float, w << 16); }
__device__ __forceinline__ float bfhi(unsigned w) { return __builtin_bit_cast(float, w & 0xffff0000u); }
__device__ __forceinline__ float wave_sum(float v) {
#pragma unroll
    for (int o = 1; o < 64; o <<= 1) v += __shfl_xor(v, o);
    return v;
}

__device__ __forceinline__ int fresh_tid() { int t = threadIdx.x; asm volatile("" : "+v"(t)); return t; }
struct Args { const void* in[18]; float* out; unsigned char* ws; int ph_lo, ph_hi; };

__device__ __forceinline__ int map_row(int kind, int n0) {
    if (kind == 0) return n0;
    if (kind == 1) return 256 * (n0 >> 7) + (n0 & 127);
    if (kind == 2) return 256 * (n0 >> 7) + 128 + (n0 & 127);
    return (n0 & ~255) + 128 * ((n0 >> 5) & 1) + 32 * ((n0 >> 6) & 3);
}
__device__ __forceinline__ void conv_item(const float* W, int K, int Npitch, int nblk, bf16_t* WT, int kind, LAS float* scr, int item, int lane) {
    const int kb = item / nblk, nb = item % nblk, k0 = 64 * kb, n0 = 32 * nb;
    const int drow0 = map_row(kind, n0);
#pragma unroll 8
    for (int i = 0; i < 32; ++i) { const int kk = 2 * i + (lane >> 5); scr[kk * 33 + (lane & 31)] = W[(size_t)(k0 + kk) * Npitch + n0 + (lane & 31)]; }
    asm volatile("s_waitcnt lgkmcnt(0)" ::: "memory");
    const int c = lane & 7;
#pragma unroll
    for (int j = 0; j < 4; ++j) { const int n = (lane >> 3) + 8 * j; const LAS float* s = scr + (8 * c) * 33 + n;
        u32x4 o; o.x = pk2(s[0 * 33], s[1 * 33]); o.y = pk2(s[2 * 33], s[3 * 33]); o.z = pk2(s[4 * 33], s[5 * 33]); o.w = pk2(s[6 * 33], s[7 * 33]);
        *(u32x4*)(WT + (size_t)(drow0 + n) * K + k0 + 8 * c) = o; }
    asm volatile("s_waitcnt lgkmcnt(0)" ::: "memory");
}

template <class AT> __device__ __forceinline__ void prologue_phase(AT& a, LAS unsigned char* lds) {
    const int tid = fresh_tid(), lane = tid & 63, wid = __builtin_amdgcn_readfirstlane(tid >> 6);
    const int G = gridDim.x, bid = blockIdx.x;
    unsigned char* ws = a.ws;
    {
        const float* c = (const float*)a.in[1]; const float* mod_w = (const float*)a.in[3]; const float* mod_b = (const float*)a.in[4];
        float* modbuf = (float*)(ws + WS_MOD);
        LAS float* cact = (LAS float*)lds;
        LAS float* red = (LAS float*)(lds + 32768);
        for (int e = tid; e < NB * DM; e += NTHREADS) { const int b = e >> 10, k = e & 1023; const float v = c[e]; cact[k * 8 + b] = v / (1.0f + __expf(-v)); }
        __syncthreads();
        for (int task = bid; task < 4 * 144; task += G) {
            const int i = task / 144, n0 = (task % 144) * 64, n = n0 + lane;
            float acc[8];
#pragma unroll
            for (int b = 0; b < 8; ++b) acc[b] = 0.f;
            const float* wp = mod_w + ((size_t)i * DM + 128 * wid) * MODN + n;
#pragma unroll 4
            for (int kk = 0; kk < 128; ++kk) {
                const float wv = wp[(size_t)kk * MODN];
                const f32x4 c0 = *(const LAS f32x4*)(cact + (128 * wid + kk) * 8), c1 = *(const LAS f32x4*)(cact + (128 * wid + kk) * 8 + 4);
                acc[0] += c0[0] * wv; acc[1] += c0[1] * wv; acc[2] += c0[2] * wv; acc[3] += c0[3] * wv;
                acc[4] += c1[0] * wv; acc[5] += c1[1] * wv; acc[6] += c1[2] * wv; acc[7] += c1[3] * wv;
            }
#pragma unroll
            for (int b = 0; b < 8; ++b) red[(wid * 8 + b) * 64 + lane] = acc[b];
            __syncthreads();
            {
                const int b = tid >> 6; float s = 0.f;
#pragma unroll
                for (int w = 0; w < 8; ++w) s += red[(w * 8 + b) * 64 + lane];
                s += mod_b[(size_t)i * MODN + n];
                const int sidx = n / 3072, j = (n >> 10) % 3;
                if (j == 1) s += 1.0f;
                if (j == 2 && sidx != 1) s *= 0.5f;
                modbuf[((size_t)i * NB + b) * MODN + n] = s;
            }
            __syncthreads();
        }
    }
    __syncthreads();
    {
        const int* pos = (const int*)a.in[2];
        float* cs = (float*)(ws + WS_COS); float* sn = (float*)(ws + WS_SIN);
        for (int e = bid * NTHREADS + tid; e < MT * 8; e += G * NTHREADS) {
            const int i = e & 7;
            const float invf = (i == 0) ? 1.0f : (i == 1) ? 0.1939227432012558f : (i == 2) ? 0.03760603070259094f : (i == 3) ? 0.007292664609849453f
                             : (i == 4) ? 0.0014142135623842478f : (i == 5) ? 0.00027424818836152554f : (i == 6) ? 5.3182957344688475e-05f : 1.0313385246263351e-05f;
            const float ang = (float)pos[e >> 3] * invf;
            const double rev = (double)ang * 0.15915494309189535;
            const float fr = (float)(rev - floor(rev));
            cs[e] = __builtin_amdgcn_cosf(fr); sn[e] = __builtin_amdgcn_sinf(fr);
        }
    }
    {
        LAS float* scr = (LAS float*)(lds + wid * 16384);
        const float* wg = (const float*)a.in[6]; const float* wu = (const float*)a.in[7]; const float* wd = (const float*)a.in[8];
        const float* fin = (const float*)a.in[9]; const float* fout = (const float*)a.in[13];
        const float* din = (const float*)a.in[14]; const float* dout = (const float*)a.in[17];
        const int gw = bid * NWAVES + wid, NGW = G * NWAVES;
        constexpr int I_FFN = 1408, I_FIN = 1536, I_OUT = 512, I_DIN = 4608;
        constexpr int NITEMS = 8 * 3 * I_FFN + 2 * I_FIN + 2 * I_OUT + 2 * I_DIN + 2 * I_OUT;
        for (int it = gw; it < NITEMS; it += NGW) {
            int r = it;
            if (r < 8 * 3 * I_FFN) {
                const int f = r / (3 * I_FFN); r -= f * 3 * I_FFN; const int w3 = r / I_FFN; r -= w3 * I_FFN;
                bf16_t* gu = (bf16_t*)(ws + WS_W + (size_t)f * FFN_BLK);
                if (w3 == 0) conv_item(wg + (size_t)f * DM * FF, DM, FF, FF / 32, gu, 1, scr, r, lane);
                else if (w3 == 1) conv_item(wu + (size_t)f * DM * FF, DM, FF, FF / 32, gu, 2, scr, r, lane);
                else conv_item(wd + (size_t)f * FF * DM, FF, DM, DM / 32, (bf16_t*)(ws + WS_W + (size_t)f * FFN_BLK + FFN_DOWN_OFF), 0, scr, r, lane);
                continue;
            }
            r -= 8 * 3 * I_FFN;
            if (r < 2 * I_FIN) { const int j = r / I_FIN; r -= j * I_FIN; conv_item(fin + (size_t)j * DM * 3088, DM, 3088, 96, (bf16_t*)(ws + WS_FOXIN + (size_t)j * FOXIN_SZ), 3, scr, r, lane); continue; }
            r -= 2 * I_FIN;
            if (r < 2 * I_OUT) { const int j = r / I_OUT; r -= j * I_OUT; conv_item(fout + (size_t)j * DM * DM, DM, DM, 32, (bf16_t*)(ws + WS_FOXOUT + (size_t)j * OUT_SZ), 0, scr, r, lane); continue; }
            r -= 2 * I_OUT;
            if (r < 2 * I_DIN) { const int j = r / I_DIN; r -= j * I_DIN; conv_item(din + (size_t)j * DM * 9216, DM, 9216, 288, (bf16_t*)(ws + WS_DILIN + (size_t)j * DILIN_SZ), 3, scr, r, lane); continue; }
            r -= 2 * I_DIN;
            { const int j = r / I_OUT; r -= j * I_OUT; conv_item(dout + (size_t)j * DM * DM, DM, DM, 32, (bf16_t*)(ws + WS_DILOUT + (size_t)j * OUT_SZ), 0, scr, r, lane); }
        }
    }
}

template <bool FOX>
__device__ __forceinline__ void norm_phase(LAS unsigned char* lds, const float* xin, const float* g, const float* sc1p, const float* shift, bf16_t* hout,
                                           const float* wf_src, const float* bfv, float* cumloc, float* chtot) {
    const int tid = fresh_tid(), lane = tid & 63, wid = __builtin_amdgcn_readfirstlane(tid >> 6);
    const int G = gridDim.x;
    LAS float* wfL = (LAS float*)lds;
    if (FOX) {
        for (int k = tid; k < DM; k += NTHREADS) {
            const float* src = wf_src + (size_t)k * 3088;
#pragma unroll
            for (int q = 0; q < 4; ++q) { const f32x4 v = *(const f32x4*)(src + 4 * q);
#pragma unroll
                for (int e = 0; e < 4; ++e) wfL[(4 * q + e) * DM + k] = v[e]; }
        }
        __syncthreads();
    }
    for (int chunk = blockIdx.x; chunk < MT / 128; chunk += G) {
        const int b = chunk >> 5;
        const int row_base = chunk * 128 + wid * 16;
        f32x4 A[4], Bc[4];
#pragma unroll
        for (int j = 0; j < 4; ++j) {
            const int col = 4 * lane + 256 * j;
            A[j] = *(const f32x4*)(g + col) * *(const f32x4*)(sc1p + (size_t)b * MODN + col);
            Bc[j] = *(const f32x4*)(shift + (size_t)b * MODN + col);
        }
        float run = 0.f;
#pragma unroll 1
        for (int rg = 0; rg < 4; ++rg) {
            f32x4 hv[4][4];
#pragma unroll
            for (int rr = 0; rr < 4; ++rr) {
                const float* xr = xin + (size_t)(row_base + rg * 4 + rr) * DM + 4 * lane;
#pragma unroll
                for (int j = 0; j < 4; ++j) hv[rr][j] = *(const f32x4*)(xr + 256 * j);
            }
#pragma unroll
            for (int rr = 0; rr < 4; ++rr) {
                float ss = 0.f;
#pragma unroll
                for (int j = 0; j < 4; ++j) { const f32x4 t = hv[rr][j] * hv[rr][j]; ss += (t[0] + t[1]) + (t[2] + t[3]); }
                ss = wave_sum(ss);
                const float rstd = 1.0f / sqrtf(ss * (1.0f / DM) + 1e-6f);
                bf16_t* orow = hout + (size_t)(row_base + rg * 4 + rr) * DM + 4 * lane;
#pragma unroll
                for (int j = 0; j < 4; ++j) {
                    hv[rr][j] = hv[rr][j] * rstd * A[j] + Bc[j];
                    u32x2 w; w.x = pk2(hv[rr][j][0], hv[rr][j][1]); w.y = pk2(hv[rr][j][2], hv[rr][j][3]);
                    *(u32x2*)(orow + 256 * j) = w;
                }
            }
            if (FOX) {
                float zs[4] = {0.f, 0.f, 0.f, 0.f};
#pragma unroll 1
                for (int hh = 0; hh < 16; ++hh) {
                    f32x4 wv[4];
#pragma unroll
                    for (int j = 0; j < 4; ++j) wv[j] = *(const LAS f32x4*)(wfL + hh * DM + 4 * lane + 256 * j);
#pragma unroll
                    for (int rr = 0; rr < 4; ++rr) {
                        float s = 0.f;
#pragma unroll
                        for (int j = 0; j < 4; ++j) { const f32x4 t = hv[rr][j] * wv[j]; s += (t[0] + t[1]) + (t[2] + t[3]); }
                        s = wave_sum(s);
                        zs[rr] = ((lane & 15) == hh) ? s : zs[rr];
                    }
                }
                const float bfl = bfv[lane & 15];
                float* cp = cumloc + ((size_t)(b * NH + (lane & 15))) * SEQ + (chunk & 31) * 128 + wid * 16 + rg * 4;
#pragma unroll
                for (int rr = 0; rr < 4; ++rr) {
                    const float z = zs[rr] + bfl;
                    const float ls = -(fmaxf(-z, 0.f) + log1pf(__expf(-fabsf(z))));
                    run += ls;
                    if (lane < 16) cp[rr] = run;
                }
            }
        }
        if (FOX) { if (lane < 16) chtot[(b * NH + lane) * 256 + (chunk & 31) * 8 + wid] = run; }
    }
}

__device__ __forceinline__ void merge_phase(const bf16_t* qkv, const float* lse, bf16_t* hout) {
    const int tid = fresh_tid(), lane = tid & 63, wid = tid >> 6;
    const int gw = blockIdx.x * NWAVES + wid, NGW = gridDim.x * NWAVES;
    const int head = lane >> 2;
    for (int row = gw; row < MT / 2; row += NGW) {
        float ls[3], w[3];
#pragma unroll
        for (int g = 0; g < 3; ++g) ls[g] = lse[((size_t)row * 3 + g) * NH + head];
        const float mx = fmaxf(ls[0], fmaxf(ls[1], ls[2]));
        float sw = 0.f;
#pragma unroll
        for (int g = 0; g < 3; ++g) { w[g] = __builtin_amdgcn_exp2f(ls[g] - mx); sw += w[g]; }
        const float inv = 1.0f / sw;
        float acc[16];
#pragma unroll
        for (int e = 0; e < 16; ++e) acc[e] = 0.f;
#pragma unroll
        for (int g = 0; g < 3; ++g) {
            const u32x4* p = (const u32x4*)(qkv + (size_t)row * 9216 + g * 3072 + 16 * lane);
            const u32x4 v0 = p[0], v1 = p[1]; const float wg = w[g] * inv;
#pragma unroll
            for (int e = 0; e < 4; ++e) { acc[2 * e] += wg * bflo(v0[e]); acc[2 * e + 1] += wg * bfhi(v0[e]); acc[8 + 2 * e] += wg * bflo(v1[e]); acc[8 + 2 * e + 1] += wg * bfhi(v1[e]); }
        }
        u32x4 o0, o1;
#pragma unroll
        for (int e = 0; e < 4; ++e) { o0[e] = pk2(acc[2 * e], acc[2 * e + 1]); o1[e] = pk2(acc[8 + 2 * e], acc[8 + 2 * e + 1]); }
        u32x4* op = (u32x4*)(hout + (size_t)row * DM + 16 * lane);
        op[0] = o0; op[1] = o1;
    }
}

__device__ __forceinline__ void fox_attn_phase(LAS unsigned char* lds, bf16_t* Qb, const bf16_t* Kb, const bf16_t* Vb, const float* cumloc, const float* chtot) {
    const int tid = fresh_tid(), lane = tid & 63;
    const int G = gridDim.x;
    LAS float* cumL = (LAS float*)(lds + att::CUM_OFF);
    LAS float* pfL = (LAS float*)(lds + att::PF_OFF);
    LAS float* wtL = (LAS float*)(lds + att::PF_OFF + 1024);
    for (int i = 0;; ++i) {
        const int id = i * G + blockIdx.x; if (id >= NB * NH * 16) break;
        const int bh = id & 127, jj = id >> 7, qb = jj ^ ((jj >> 1) & 1);
        __syncthreads();
        {
            float v = (tid < 256) ? chtot[bh * 256 + tid] : 0.f; const float own = v;
#pragma unroll
            for (int off = 1; off < 64; off <<= 1) { const float t = __shfl_up(v, off); if (lane >= off) v += t; }
            if (lane == 63 && tid < 256) wtL[tid >> 6] = v;
            __syncthreads();
            float pre = 0.f;
            for (int w = 0; w < (tid >> 6); ++w) pre += (w < 4) ? wtL[w] : 0.f;
            if (tid < 256) pfL[tid] = v - own + pre;
        }
        __syncthreads();
        const int nk = qb * 256 + 256;
        for (int s = tid; s < nk; s += NTHREADS) cumL[s] = -(cumloc[(size_t)bh * SEQ + s] + pfL[s >> 4]) * LOG2E;
        att::Unit U;
        const size_t base = (size_t)(bh >> 4) * SEQ * DM + (size_t)(bh & 15) * 64;
        U.Q = Qb + base; U.K = Kb + base; U.V = Vb + base; U.O = Qb + base; U.stride = DM;
        U.q0 = qb * 256; U.t_lo = 0; U.t_hi = 4 * qb + 4; U.window = 1 << 30; U.bias = 1; U.lse = nullptr; U.lse_stride = 0;
        att::unit_run(lds, U);
    }
}
__device__ __forceinline__ void dil_attn_phase(LAS unsigned char* lds, bf16_t* qkv, float* lse) {
    const int G = gridDim.x;
    for (int i = 0;; ++i) {
        const int id = i * G + blockIdx.x; if (id >= 4 * NH * 48) break;
        const int sub = id & 15, g = (id >> 4) % 3, h = (id / 48) & 15, bl = id / 768;
        int d, rho, blk;
        if (g == 0) { d = 1; rho = 0; blk = sub; } else if (g == 1) { d = 4; rho = sub >> 2; blk = sub & 3; } else { d = 16; rho = sub; blk = 0; }
        __syncthreads();
        att::Unit U;
        const size_t rowl = (size_t)bl * SEQ + rho;
        bf16_t* qp = qkv + rowl * 9216 + (size_t)g * 3072 + h * 64;
        U.Q = qp; U.K = qp + 1024; U.V = qp + 2048; U.O = qp; U.stride = (long)d * 9216;
        U.q0 = blk * 256; U.t_lo = (4 * blk - 2 > 0) ? 4 * blk - 2 : 0; U.t_hi = 4 * blk + 4; U.window = 128; U.bias = 0;
        U.lse = lse + (rowl * 3 + g) * NH + h; U.lse_stride = (long)d * 48;
        att::unit_run(lds, U);
    }
}

#ifndef PMASK
#define PMASK 255
#endif
enum { OP_NORM = 0, OP_GU = 1, OP_DOWN = 2, OP_QKV = 3, OP_ATT = 4, OP_OUT = 5, OP_PROJ = 6, OP_DATT = 7, OP_MERGE = 8 };
constexpr int N_PHASES = 1 + 2 * 10 + 2 * 14;

typedef const Args __attribute__((address_space(4))) CArgs;
__device__ __forceinline__ CArgs& fresh_args() { unsigned long long p = (unsigned long long)__builtin_amdgcn_kernarg_segment_ptr(); asm volatile("" : "+s"(p)); return *(CArgs*)p; }
__device__ __forceinline__ void run_phase(LAS unsigned char* lds, int ph) {
    CArgs& a = fresh_args();
    if (ph == 0) { if (PMASK & 1) prologue_phase(a, lds); return; }
    int p = ph - 1, layer = 0, n;
    for (;;) { n = (layer & 1) ? 14 : 10; if (p < n) break; p -= n; ++layer; }
    const bool dil = (layer & 1) != 0; const int j = layer >> 1;
    int op, sub, hb = 0, ffn = 0;
    if (p < 3) { sub = 0; ffn = 0; op = p; }
    else if (p >= n - 3) { sub = 2; ffn = 1; op = p - (n - 3); }
    else { sub = 1; const int q = p - 3;
        if (!dil) op = (q == 0) ? OP_NORM : (q == 1) ? OP_QKV : (q == 2) ? OP_ATT : OP_OUT;
        else if (q == 0) op = OP_NORM; else if (q == 7) op = OP_OUT; else { hb = (q - 1) / 3; const int r = (q - 1) % 3; op = (r == 0) ? OP_PROJ : (r == 1) ? OP_DATT : OP_MERGE; } }
    unsigned char* ws = a.ws;
    const float* x0 = (const float*)a.in[0];
    float* xo = a.out;
    const bool first = (layer == 0 && sub == 0);
    const float* xin = first ? x0 : (const float*)xo;
    const float* modl = (const float*)(ws + WS_MOD) + (size_t)layer * NB * MODN + (size_t)sub * 3 * DM;
    bf16_t* HB = (bf16_t*)(ws + WS_H);
    bf16_t* BIG = (bf16_t*)(ws + WS_BIG);
    const int G = gridDim.x, bid = blockIdx.x;
    const int f = layer * 2 + ffn;
    if (op == OP_NORM && (PMASK & 2)) {
        const float* g = (const float*)a.in[5] + (size_t)(layer * 3 + sub) * DM;
        if (sub == 1 && !dil)
            norm_phase<true>(lds, xin, g, modl + DM, modl, HB, (const float*)a.in[9] + (size_t)j * DM * 3088 + 3072, (const float*)a.in[10] + j * NH, (float*)(ws + WS_CUM), (float*)(ws + WS_CHT));
        else
            norm_phase<false>(lds, xin, g, modl + DM, modl, HB, nullptr, nullptr, nullptr, nullptr);
    } else if ((op == OP_GU || op == OP_DOWN || op == OP_OUT || op == OP_QKV || op == OP_PROJ) && (PMASK & 4)) {
        pg8::Gemm gm; pg8::StaticOrder S; pg8::EpiAny E;
        E.kind = 0; E.s.Hd = BIG; E.r.xin = xin; E.r.xout = xo; E.r.coef = modl + 2 * DM;
        E.q.out = BIG; E.q.fox = 1; E.q.qg = nullptr; E.q.kg = nullptr; E.q.cs = nullptr; E.q.sn = nullptr;
        if (op == OP_GU) { gm = pg8::Gemm{HB, (const bf16_t*)(ws + WS_W + (size_t)f * FFN_BLK), MT, 2 * FF, DM}; E.kind = 0; }
        else if (op == OP_DOWN) { gm = pg8::Gemm{BIG, (const bf16_t*)(ws + WS_W + (size_t)f * FFN_BLK + FFN_DOWN_OFF), MT, DM, FF}; E.kind = 1; }
        else if (op == OP_OUT) { E.kind = 1;
            if (!dil) gm = pg8::Gemm{BIG, (const bf16_t*)(ws + WS_FOXOUT + (size_t)j * OUT_SZ), MT, DM, DM};
            else gm = pg8::Gemm{HB, (const bf16_t*)(ws + WS_DILOUT + (size_t)j * OUT_SZ), MT, DM, DM}; }
        else if (op == OP_QKV) { E.kind = 2;
            gm = pg8::Gemm{HB, (const bf16_t*)(ws + WS_FOXIN + (size_t)j * FOXIN_SZ), MT, 3072, DM};
            E.q.qg = (const float*)a.in[11] + j * 64; E.q.kg = (const float*)a.in[12] + j * 64; }
        else { E.kind = 2; E.q.fox = 0;
            gm = pg8::Gemm{HB + (size_t)hb * (MT / 2) * DM, (const bf16_t*)(ws + WS_DILIN + (size_t)j * DILIN_SZ), MT / 2, 9216, DM};
            E.q.qg = (const float*)a.in[15] + j * 192; E.q.kg = (const float*)a.in[16] + j * 192;
            E.q.cs = (const float*)(ws + WS_COS) + (size_t)hb * (MT / 2) * 8; E.q.sn = (const float*)(ws + WS_SIN) + (size_t)hb * (MT / 2) * 8; }
        S.init(gm.M, gm.N, G, bid);
        pg8::gemm_phase<pg8::EpiAny, pg8::StaticOrder, true, true>(lds, gm, S, E);
    } else if (op == OP_ATT && (PMASK & 32)) {
        fox_attn_phase(lds, BIG, BIG + (size_t)MT * DM, BIG + (size_t)2 * MT * DM, (const float*)(ws + WS_CUM), (const float*)(ws + WS_CHT));
    } else if (op == OP_DATT && (PMASK & 64)) {
        dil_attn_phase(lds, BIG, (float*)(ws + WS_LSE));
    } else if (op == OP_MERGE && (PMASK & 128)) {
        merge_phase(BIG, (const float*)(ws + WS_LSE), HB + (size_t)hb * (MT / 2) * DM);
    }
}

#ifndef MK_COOP
#define MK_COOP 1
#endif

__global__ void __launch_bounds__(NTHREADS, 2) mk_fwd(Args a) {
    extern __shared__ __attribute__((aligned(16))) unsigned char lds_raw[];
    LAS unsigned char* lds = (LAS unsigned char*)lds_raw;
    const int lo = fresh_args().ph_lo;
    for (int ph = lo;; ++ph) {
        run_phase(lds, ph);
        if (ph + 1 >= fresh_args().ph_hi) break;
        cg::this_grid().sync();
    }
}

extern "C" void kernel_launch(void* const* d_in, const int* in_sizes, int n_in, void* d_out, int out_size, void* d_ws, size_t ws_size, hipStream_t stream) {
    static int grid = 0;
    if (grid == 0) {
        if (n_in != 18 || out_size != MT * DM || ws_size < WS_END) { fprintf(stderr, "kernel_launch: unexpected shapes (n_in %d, out %d, ws %zu; need ws >= %zu)\n", n_in, out_size, ws_size, (size_t)WS_END); grid = -1; return; }
        int dev = 0, cus = 0, per_cu = 0;
        if (hipGetDevice(&dev) != hipSuccess || hipDeviceGetAttribute(&cus, hipDeviceAttributeMultiprocessorCount, dev) != hipSuccess) { grid = -1; return; }
        if (hipFuncSetAttribute((const void*)mk_fwd, hipFuncAttributeMaxDynamicSharedMemorySize, LDS_BYTES) != hipSuccess) { fprintf(stderr, "kernel_launch: hipFuncSetAttribute failed\n"); grid = -1; return; }
        if (hipOccupancyMaxActiveBlocksPerMultiprocessor(&per_cu, (const void*)mk_fwd, NTHREADS, LDS_BYTES) != hipSuccess || per_cu < 1) { per_cu = 1; (void)hipGetLastError(); }
        grid = cus * per_cu;
    }
    if (grid < 0) return;
    Args a{};
    for (int i = 0; i < 18; ++i) a.in[i] = d_in[i];
    a.out = (float*)d_out; a.ws = (unsigned char*)d_ws;
#if MK_COOP
    a.ph_lo = 0; a.ph_hi = N_PHASES;
    void* args[] = {&a};
    hipError_t e = hipLaunchCooperativeKernel((const void*)mk_fwd, dim3(grid), dim3(NTHREADS), args, LDS_BYTES, stream);
    if (e != hipSuccess) fprintf(stderr, "cooperative launch failed: %s (grid %d)\n", hipGetErrorString(e), grid);
#else
    for (int ph = 0; ph < N_PHASES; ++ph) {
        a.ph_lo = ph; a.ph_hi = ph + 1;
        hipLaunchKernelGGL(mk_fwd, dim3(grid), dim3(NTHREADS), LDS_BYTES, stream, a);
    }
#endif
}
```

```cpp
#include <hip/hip_runtime.h>
#include <hip/hip_cooperative_groups.h>
#include <cstdio>
#include <cstdint>
#include <cmath>
namespace cg = cooperative_groups;
namespace pg8 {
#define PG8_LAS __attribute__((address_space(3)))
typedef unsigned short bf16_t;
typedef short bf16x8 __attribute__((ext_vector_type(8)));
typedef float f32x4 __attribute__((ext_vector_type(4)));
typedef unsigned u32x4 __attribute__((ext_vector_type(4)));
constexpr int BM = 256, BK = 64, HALF = 128, HTB = HALF * BK * 2  , STAGE_BYTES = 8 * HTB, NXCD = 8, WGM = 8;

__host__ __device__ __forceinline__ int lds_byte(int r, int c) { const int st = (r >> 4) * 2 + (c >> 5), rr = r & 15, cc = c & 31, ob = rr * 64 + cc * 2; return st * 1024 + (ob ^ (((ob >> 9) & 1) << 5)); }
__host__ __device__ __forceinline__ void stage_rc(int b, int& R, int& C) { const int st = b / 1024, sb = b % 1024, swz = sb ^ (((sb >> 9) & 1) << 5); R = (st >> 1) * 16 + swz / 64; C = (st & 1) * 32 + (swz % 64) / 2; }
__host__ __device__ __forceinline__ int perm32(int rho) { const int n = rho >> 4, i = rho & 15; return 8 * (i >> 2) + 4 * n + (i & 3); }

struct Unit { int pm, pn; };
struct Gemm { const bf16_t* A; const bf16_t* Bt; int M, N, K; };

struct StaticOrder {
    int nM, nN, nwg, G, c;
    __host__ __device__ void init(int M, int N, int G_, int c_) { nM = M / BM; nN = N / BM; nwg = nM * nN; G = G_; c = c_; }
    __host__ __device__ bool next(int i, Unit& u) const {
        const long L = (long)i * G + c; if (L >= nwg) return false;
        int wgid = (int)L; { const int q = nwg / NXCD, r = nwg % NXCD, xcd = wgid % NXCD, off = wgid / NXCD; wgid = (xcd < r ? xcd * (q + 1) : r * (q + 1) + (xcd - r) * q) + off; }
        const int nig = WGM * nN, gid = wgid / nig, fm = gid * WGM, gsz = (nM - fm) < WGM ? (nM - fm) : WGM;
        u.pm = fm + ((wgid % nig) % gsz); u.pn = (wgid % nig) / gsz; return true;
    }
    __device__ __forceinline__ void a_ready(const Unit&) const {}
    __device__ __forceinline__ void done(const Unit&) const {}
};

__device__ __forceinline__ unsigned cvt_pk_bf16(float lo, float hi) { unsigned r; asm volatile("v_cvt_pk_bf16_f32 %0, %1, %2" : "=v"(r) : "v"(lo), "v"(hi)); return r; }
typedef float f32x2 __attribute__((ext_vector_type(2)));
constexpr int P_MT = 32768, P_DM = 1024, P_FF = 2816, P_MODN = 9216;
constexpr float P_C2 = 0.125f * 1.4426950408889634f;

struct EpiSwiGLU {
    static constexpr bool PERM = true, AFTER_DRAIN = false;
    bf16_t* Hd;
    __device__ __forceinline__ void operator()(const f32x4 (&acc)[2][2][4][2], const Unit& u, int wr, int wc, int fr, int fq) const {
        const int row0 = u.pm * BM + wr * 64 + fr, col0 = u.pn * 128 + wc * 32 + 8 * fq;
#pragma unroll
        for (int ai = 0; ai < 2; ++ai)
#pragma unroll
            for (int m = 0; m < 4; ++m) {
                bf16_t* rowp = Hd + (size_t)(row0 + ai * HALF + m * 16) * P_FF + col0;
                float v[8];
#pragma unroll
                for (int n = 0; n < 2; ++n)
#pragma unroll
                    for (int e = 0; e < 4; ++e) {
                        const float g = acc[ai][0][m][n][e], up = acc[ai][1][m][n][e];
                        const float s = __builtin_amdgcn_rcpf(1.0f + __builtin_amdgcn_exp2f(-1.4426950408889634f * g));
                        v[n * 4 + e] = g * s * up;
                    }
                u32x4 w; w.x = cvt_pk_bf16(v[0], v[1]); w.y = cvt_pk_bf16(v[2], v[3]); w.z = cvt_pk_bf16(v[4], v[5]); w.w = cvt_pk_bf16(v[6], v[7]);
                *(u32x4*)rowp = w;
            }
    }
};

struct EpiResid {
    static constexpr bool PERM = true, AFTER_DRAIN = false;
    const float* xin; float* xout; const float* coef;
    __device__ __forceinline__ void operator()(const f32x4 (&acc)[2][2][4][2], const Unit& u, int wr, int wc, int fr, int fq) const {
        const int row0 = u.pm * BM + wr * 64 + fr, col0 = u.pn * BM + wc * 32 + 8 * fq;
        const float* cf = coef + (size_t)(u.pm >> 4) * P_MODN + col0;
        f32x4 cv[2][2];
#pragma unroll
        for (int bj = 0; bj < 2; ++bj)
#pragma unroll
            for (int n = 0; n < 2; ++n) cv[bj][n] = *(const f32x4*)(cf + bj * HALF + n * 4);
#pragma unroll
        for (int ai = 0; ai < 2; ++ai)
#pragma unroll
            for (int m = 0; m < 4; ++m) {
                const size_t off = (size_t)(row0 + ai * HALF + m * 16) * P_DM + col0;
#pragma unroll
                for (int bj = 0; bj < 2; ++bj)
#pragma unroll
                    for (int n = 0; n < 2; ++n) {
                        const f32x4 xi = *(const f32x4*)(xin + off + bj * HALF + n * 4);
                        *(f32x4*)(xout + off + bj * HALF + n * 4) = xi + cv[bj][n] * acc[ai][bj][m][n];
                    }
            }
    }
};

struct EpiQKV {
    static constexpr bool PERM = true, AFTER_DRAIN = false;
    bf16_t* out; int fox; const float* qg; const float* kg; const float* cs; const float* sn;
    __device__ __forceinline__ void operator()(const f32x4 (&acc)[2][2][4][2], const Unit& u, int wr, int wc, int fr, int fq) const {
        int which, colbase, pitch; bf16_t* base; const float* gq; const float* gk;
        if (fox) { which = u.pn >> 2; base = out + (size_t)which * ((size_t)P_MT * P_DM); pitch = P_DM; colbase = (u.pn & 3) * 256; gq = qg; gk = kg; }
        else { const int grp = u.pn / 12; which = (u.pn % 12) >> 2; base = out; pitch = 9216; colbase = u.pn * 256; gq = qg + grp * 64; gk = kg + grp * 64; }
        const int row0 = u.pm * BM + wr * 64 + fr;
        const int cw = colbase + wc * 64 + 8 * fq;
        if (which == 2) {
#pragma unroll
            for (int ai = 0; ai < 2; ++ai)
#pragma unroll
                for (int m = 0; m < 4; ++m) {
                    bf16_t* rowp = base + (size_t)(row0 + ai * HALF + m * 16) * pitch + cw;
#pragma unroll
                    for (int bj = 0; bj < 2; ++bj) {
                        const f32x4 v0 = acc[ai][bj][m][0], v1 = acc[ai][bj][m][1];
                        u32x4 w; w.x = cvt_pk_bf16(v0[0], v0[1]); w.y = cvt_pk_bf16(v0[2], v0[3]); w.z = cvt_pk_bf16(v1[0], v1[1]); w.w = cvt_pk_bf16(v1[2], v1[3]);
                        *(u32x4*)(rowp + bj * 32) = w;
                    }
                }
        } else {
            const float* gp = (which == 0) ? gq : gk; const float osc = (which == 0) ? P_C2 : 1.0f;
            f32x4 gv[2][2];
#pragma unroll
            for (int bj = 0; bj < 2; ++bj)
#pragma unroll
                for (int n = 0; n < 2; ++n) gv[bj][n] = *(const f32x4*)(gp + 32 * bj + 8 * fq + 4 * n) * osc;
#pragma unroll
            for (int ai = 0; ai < 2; ++ai)
#pragma unroll
                for (int m = 0; m < 4; ++m) {
                    const int row = row0 + ai * HALF + m * 16;
                    f32x4 v[2][2]; float ss = 0.f;
#pragma unroll
                    for (int bj = 0; bj < 2; ++bj)
#pragma unroll
                        for (int n = 0; n < 2; ++n) { v[bj][n] = acc[ai][bj][m][n]; const f32x4 t = v[bj][n] * v[bj][n]; ss += (t[0] + t[1]) + (t[2] + t[3]); }
                    ss += __shfl_xor(ss, 16); ss += __shfl_xor(ss, 32);
                    const float rstd = 1.0f / sqrtf(ss * (1.0f / 64.0f) + 1e-6f);
#pragma unroll
                    for (int bj = 0; bj < 2; ++bj)
#pragma unroll
                        for (int n = 0; n < 2; ++n) v[bj][n] = v[bj][n] * rstd * gv[bj][n];
                    if (!fox) {
#pragma unroll
                        for (int n = 0; n < 2; ++n) {
                            const f32x4 c = *(const f32x4*)(cs + (size_t)row * 8 + 4 * n), s = *(const f32x4*)(sn + (size_t)row * 8 + 4 * n);
                            f32x4 oth;
#pragma unroll
                            for (int e = 0; e < 4; ++e) oth[e] = __shfl_xor(v[0][n][e], 16);
                            const f32x4 r0 = v[0][n] * c - oth * s, r1 = v[0][n] * c + oth * s;
                            v[0][n] = (fq == 0) ? r0 : ((fq == 1) ? r1 : v[0][n]);
                        }
                    }
                    bf16_t* rowp = base + (size_t)row * pitch + cw;
#pragma unroll
                    for (int bj = 0; bj < 2; ++bj) {
                        const f32x4 v0 = v[bj][0], v1 = v[bj][1];
                        u32x4 w; w.x = cvt_pk_bf16(v0[0], v0[1]); w.y = cvt_pk_bf16(v0[2], v0[3]); w.z = cvt_pk_bf16(v1[0], v1[1]); w.w = cvt_pk_bf16(v1[2], v1[3]);
                        *(u32x4*)(rowp + bj * 32) = w;
                    }
                }
        }
    }
};

struct EpiAny {
    static constexpr bool PERM = true, AFTER_DRAIN = false;
    int kind; EpiSwiGLU s; EpiResid r; EpiQKV q;
    __device__ __forceinline__ void operator()(const f32x4 (&acc)[2][2][4][2], const Unit& u, int wr, int wc, int fr, int fq) const {
        if (kind == 0) s(acc, u, wr, wc, fr, fq); else if (kind == 1) r(acc, u, wr, wc, fr, fq); else q(acc, u, wr, wc, fr, fq);
    }
};
template <class Epi, class Sched, bool ALIGN_EPI = false, bool SP2 = false>
__device__ __forceinline__ void gemm_phase(PG8_LAS unsigned char* lds, const Gemm g, const Sched& S, const Epi& E) {
    int tid_ = threadIdx.x; asm volatile("" : "+v"(tid_)); const int tid = tid_, wid = __builtin_amdgcn_readfirstlane(tid >> 6), lane = tid & 63, wr = wid >> 2, wc = wid & 3, fr = lane & 15, fq = lane >> 4;
    const int K = g.K, nt = K / BK;
    unsigned voffA[2], voffB[2];
#pragma unroll
    for (int i = 0; i < 2; ++i) { int R, C; stage_rc(tid * 16 + i * 8192, R, C); const int Rb = Epi::PERM ? ((R & ~31) + perm32(R & 31)) : R;
        voffA[i] = (unsigned)(R * K + C) * 2u; voffB[i] = (unsigned)(Rb * K + C) * 2u; }
    const size_t kstep = (size_t)(BK * 2);
    const size_t hstep = (size_t)HALF * K * 2;
    const size_t tstep = 2 * hstep;
    const unsigned ldsw = (unsigned)wid * 1024u;
    const int aoff = lds_byte(wr * 64 + fr, fq * 8), boff = lds_byte(wc * 32 + fr, fq * 8);
#define PG8_SA(b, h) (((b) * 2 + (h)) * HTB)
#define PG8_SB(b, h) ((4 + (b) * 2 + (h)) * HTB)
#define PG8_STAGE(bufoff, gbase, voff) do { _Pragma("unroll") for (int _i = 0; _i < 2; ++_i) \
        __builtin_amdgcn_global_load_lds((const unsigned*)((const char*)(gbase) + (voff)[_i]), (PG8_LAS unsigned*)(lds + (bufoff) + ldsw + _i * 8192), 16, 0, 0); } while (0)
#define PG8_LDA(dst, b, h) do { _Pragma("unroll") for (int m = 0; m < 4; ++m) _Pragma("unroll") for (int k = 0; k < 2; ++k) dst[m][k] = *(const PG8_LAS bf16x8*)(lds + PG8_SA(b, h) + aoff + m * 2048 + k * 1024); } while (0)
#define PG8_LDB(dst, b, h) do { _Pragma("unroll") for (int n = 0; n < 2; ++n) _Pragma("unroll") for (int k = 0; k < 2; ++k) dst[n][k] = *(const PG8_LAS bf16x8*)(lds + PG8_SB(b, h) + boff + n * 2048 + k * 1024); } while (0)
#define PG8_MMA(ai, bj, At, Bt) do { __builtin_amdgcn_s_setprio(1); _Pragma("unroll") for (int m = 0; m < 4; ++m) _Pragma("unroll") for (int n = 0; n < 2; ++n) _Pragma("unroll") for (int k = 0; k < 2; ++k) \
        acc[ai][bj][m][n] = __builtin_amdgcn_mfma_f32_16x16x32_bf16(Bt[n][k], At[m][k], acc[ai][bj][m][n], 0, 0, 0); __builtin_amdgcn_s_setprio(0); } while (0)
#define PG8_WAIT_V(n) asm volatile("s_waitcnt vmcnt(" #n ")" ::: "memory")
#define PG8_WAIT_L(n) asm volatile("s_waitcnt lgkmcnt(" #n ")" ::: "memory")
#define PG8_BAR __builtin_amdgcn_s_barrier()
#define PG8_SCHED __builtin_amdgcn_sched_barrier(0)
    Unit cur, nxt; int ui = 0;
    if (!S.next(0, cur)) return;
    f32x4 acc[2][2][4][2];
#pragma unroll
    for (int a = 0; a < 2; ++a)
#pragma unroll
        for (int b = 0; b < 2; ++b)
#pragma unroll
            for (int m = 0; m < 4; ++m)
#pragma unroll
                for (int n = 0; n < 2; ++n) acc[a][b][m][n] = (f32x4){0.f, 0.f, 0.f, 0.f};
    bf16x8 At[4][2], B0[2][2], B1[2][2];
    const char* cA = (const char*)g.A + (size_t)cur.pm * tstep; const char* cB = (const char*)g.Bt + (size_t)cur.pn * tstep;
    S.a_ready(cur);
    if constexpr (SP2) {
        PG8_STAGE(PG8_SB(0, 0), cB, voffB); PG8_STAGE(PG8_SB(0, 1), cB + hstep, voffB); PG8_STAGE(PG8_SA(0, 0), cA, voffA); PG8_STAGE(PG8_SA(0, 1), cA + hstep, voffA);
        if (wr == 1) PG8_BAR;
        PG8_WAIT_V(2); PG8_BAR;
        PG8_STAGE(PG8_SB(1, 0), cB + kstep, voffB); PG8_STAGE(PG8_SA(1, 0), cA + kstep, voffA); PG8_STAGE(PG8_SB(1, 1), cB + hstep + kstep, voffB);
        PG8_WAIT_V(6); PG8_BAR;
    } else {
        PG8_STAGE(PG8_SB(0, 0), cB, voffB); PG8_STAGE(PG8_SA(0, 0), cA, voffA); PG8_STAGE(PG8_SB(0, 1), cB + hstep, voffB); PG8_STAGE(PG8_SA(0, 1), cA + hstep, voffA);
        if (wr == 1) PG8_BAR;
        PG8_WAIT_V(4); PG8_BAR;
        PG8_STAGE(PG8_SB(1, 0), cB + kstep, voffB); PG8_STAGE(PG8_SA(1, 0), cA + kstep, voffA); PG8_STAGE(PG8_SB(1, 1), cB + hstep + kstep, voffB);
        PG8_WAIT_V(6); PG8_BAR;
    }
    for (;;) {
        const bool has_next = S.next(ui + 1, nxt);
        const char* nA = has_next ? (const char*)g.A + (size_t)nxt.pm * tstep : cA; const char* nB = has_next ? (const char*)g.Bt + (size_t)nxt.pn * tstep : cB;
        for (int t = 0; t < nt; t += 2) {
            const bool last = (t == nt - 2);
            const char* a1 = cA + (size_t)(t + 1) * kstep;
            const char* a2 = last ? nA : cA + (size_t)(t + 2) * kstep; const char* b2 = last ? nB : cB + (size_t)(t + 2) * kstep;
            const char* a3 = a2 + kstep; const char* b3 = b2 + kstep;
            if (last && has_next) S.a_ready(nxt);
            if constexpr (SP2) {
            PG8_LDB(B0, 0, 0); PG8_LDB(B1, 0, 1); PG8_SCHED; PG8_LDA(At, 0, 0); PG8_STAGE(PG8_SA(1, 1), a1 + hstep, voffA);
            PG8_WAIT_V(8); PG8_WAIT_L(0); PG8_BAR; PG8_MMA(0, 0, At, B0); PG8_MMA(0, 1, At, B1); PG8_BAR; PG8_SCHED;
            PG8_LDA(At, 0, 1); PG8_STAGE(PG8_SB(0, 0), b2, voffB); PG8_STAGE(PG8_SB(0, 1), b2 + hstep, voffB); PG8_STAGE(PG8_SA(0, 0), a2, voffA);
            PG8_WAIT_V(8); PG8_WAIT_L(0); PG8_BAR; PG8_MMA(1, 0, At, B0); PG8_MMA(1, 1, At, B1); PG8_BAR; PG8_SCHED;
            PG8_LDB(B0, 1, 0); PG8_LDB(B1, 1, 1); PG8_SCHED; PG8_LDA(At, 1, 0); PG8_STAGE(PG8_SA(0, 1), a2 + hstep, voffA);
            PG8_WAIT_V(8); PG8_WAIT_L(0); PG8_BAR; PG8_MMA(0, 0, At, B0); PG8_MMA(0, 1, At, B1); PG8_BAR; PG8_SCHED;
            PG8_LDA(At, 1, 1); PG8_STAGE(PG8_SB(1, 0), b3, voffB); PG8_STAGE(PG8_SB(1, 1), b3 + hstep, voffB); PG8_STAGE(PG8_SA(1, 0), a3, voffA);
            PG8_WAIT_V(8); PG8_WAIT_L(0); PG8_BAR; PG8_MMA(1, 0, At, B0); PG8_MMA(1, 1, At, B1); PG8_BAR; PG8_SCHED;
            } else {
            PG8_LDB(B0, 0, 0); PG8_SCHED; PG8_LDA(At, 0, 0); PG8_STAGE(PG8_SA(1, 1), a1 + hstep, voffA);
            PG8_WAIT_L(8); PG8_BAR; PG8_WAIT_L(0); PG8_MMA(0, 0, At, B0); PG8_BAR; PG8_SCHED;
            PG8_LDB(B1, 0, 1); PG8_STAGE(PG8_SB(0, 0), b2, voffB);
            PG8_BAR; PG8_WAIT_L(0); PG8_MMA(0, 1, At, B1); PG8_BAR;
            PG8_LDA(At, 0, 1); PG8_STAGE(PG8_SA(0, 0), a2, voffA);
            PG8_BAR; PG8_WAIT_L(0); PG8_MMA(1, 0, At, B0); PG8_BAR; PG8_SCHED;
            PG8_STAGE(PG8_SB(0, 1), b2 + hstep, voffB);
            PG8_WAIT_V(6); PG8_BAR; PG8_MMA(1, 1, At, B1); PG8_BAR;
            PG8_LDB(B0, 1, 0); PG8_SCHED; PG8_LDA(At, 1, 0); PG8_STAGE(PG8_SA(0, 1), a2 + hstep, voffA);
            PG8_WAIT_L(8); PG8_BAR; PG8_WAIT_L(0); PG8_MMA(0, 0, At, B0); PG8_BAR; PG8_SCHED;
            PG8_LDB(B1, 1, 1); PG8_STAGE(PG8_SB(1, 0), b3, voffB);
            PG8_BAR; PG8_WAIT_L(0); PG8_MMA(0, 1, At, B1); PG8_BAR;
            PG8_LDA(At, 1, 1); PG8_STAGE(PG8_SA(1, 0), a3, voffA);
            PG8_BAR; PG8_WAIT_L(0); PG8_MMA(1, 0, At, B0); PG8_BAR; PG8_SCHED;
            PG8_STAGE(PG8_SB(1, 1), b3 + hstep, voffB);
            PG8_WAIT_V(6); PG8_BAR; PG8_MMA(1, 1, At, B1); PG8_BAR;
            }
        }
        if constexpr (ALIGN_EPI) { if (wr == 0) PG8_BAR; }
        if constexpr (!Epi::AFTER_DRAIN) { E(acc, cur, wr, wc, fr, fq); S.done(cur); }
        if (!has_next) break;
#pragma unroll
        for (int a = 0; a < 2; ++a)
#pragma unroll
            for (int b = 0; b < 2; ++b)
#pragma unroll
                for (int m = 0; m < 4; ++m)
#pragma unroll
                    for (int n = 0; n < 2; ++n) acc[a][b][m][n] = (f32x4){0.f, 0.f, 0.f, 0.f};
        cur = nxt; cA = nA; cB = nB; ++ui;
        if constexpr (ALIGN_EPI) { if (wr == 1) PG8_BAR; }
    }
    PG8_WAIT_V(0);
    if constexpr (!ALIGN_EPI) { if (wr == 0) PG8_BAR; }
    PG8_BAR;
    if constexpr (Epi::AFTER_DRAIN) { E.fused(acc, cur, wr, wc, fr, fq, lds, wid, lane); S.done(cur); }
#undef PG8_SA
#undef PG8_SB
#undef PG8_STAGE
#undef PG8_LDA
#undef PG8_LDB
#undef PG8_MMA
#undef PG8_WAIT_V
#undef PG8_WAIT_L
#undef PG8_BAR
#undef PG8_SCHED
}
}
namespace att {
#define LAS __attribute__((address_space(3)))
typedef unsigned short bf16_t;
typedef short bf16x8 __attribute__((ext_vector_type(8)));
typedef short s16x4 __attribute__((ext_vector_type(4)));
typedef short v4i16_t __attribute__((ext_vector_type(4)));
typedef float f32x4 __attribute__((ext_vector_type(4)));
typedef float f32x16 __attribute__((ext_vector_type(16)));
typedef unsigned u32x4 __attribute__((ext_vector_type(4)));
constexpr int KOFF = 0, VOFF = 16384, CUM_OFF = 32768, WSF_OFF = 49152, PF_OFF = 51200;
constexpr float LOG2E = 1.4426950408889634f;
__device__ __forceinline__ int crow(int r, int hi) { return (r & 3) + 8 * (r >> 2) + 4 * hi; }
__device__ __forceinline__ unsigned cvtpk(float lo, float hi) { unsigned r; asm volatile("v_cvt_pk_bf16_f32 %0, %1, %2" : "=v"(r) : "v"(lo), "v"(hi)); return r; }
__device__ __forceinline__ s16x4 vtr(const LAS unsigned char* p) { return __builtin_bit_cast(s16x4, __builtin_amdgcn_ds_read_tr16_b64_v4i16((LAS v4i16_t*)p)); }

struct Unit {
    const bf16_t* Q; const bf16_t* K; const bf16_t* V; bf16_t* O;
    long stride;
    int q0, t_lo, t_hi, window;
    int bias;
    float* lse; long lse_stride;
};

__device__ __forceinline__ void unit_run(LAS unsigned char* lds, const Unit& U) {
    int tid_ = threadIdx.x; asm volatile("" : "+v"(tid_)); const int tid = tid_, lane = tid & 63, r32 = lane & 31, hi = lane >> 5;
    const int wid = __builtin_amdgcn_readfirstlane(tid >> 6);
    const int srow = tid >> 3, sch = tid & 7;
    const bf16_t* kg = U.K + (long)srow * U.stride + sch * 8;
    const bf16_t* vg = U.V + (long)srow * U.stride + sch * 8;
    const int kst = KOFF + sch * 1024 + srow * 16;
    const int vst = VOFF + (sch >> 2) * 4096 + srow * 64 + (sch & 3) * 16;
    const int uq = U.q0 + wid * 32 + r32;
    bf16x8 qr[4];
#pragma unroll
    for (int d0 = 0; d0 < 4; ++d0) qr[d0] = *(const bf16x8*)(U.Q + (long)uq * U.stride + d0 * 16 + hi * 8);
    float m = -1e30f, l = 0.f;
    f32x16 o0, o1;
#pragma unroll
    for (int r = 0; r < 16; ++r) { o0[r] = 0.f; o1[r] = 0.f; }
    LAS float* wsf = (LAS float*)(lds + WSF_OFF) + wid * 64;
    const LAS float* cumL = (const LAS float*)(lds + CUM_OFF);
    const int wq_lo = U.q0 + wid * 32, wq_hi = wq_lo + 31;
    u32x4 kreg, vreg;
    {
        const long go = (long)U.t_lo * 64 * U.stride;
        kreg = *(const u32x4*)(kg + go); vreg = *(const u32x4*)(vg + go);
        *(LAS u32x4*)(lds + kst) = kreg; *(LAS u32x4*)(lds + vst) = vreg;
    }
    const LAS unsigned char* vp0 = lds + VOFF + ((lane >> 4) & 1) * 32 + (lane & 3) * 8 + (4 * hi + ((lane & 15) >> 2)) * 64;
    const LAS unsigned char* kp0 = lds + KOFF + hi * 1024 + r32 * 16;
    for (int t = U.t_lo; t < U.t_hi; ++t) {
        const int cur = (t - U.t_lo) & 1;
        const bool more = (t + 1 < U.t_hi);
        if (more) { const long go = (long)(t + 1) * 64 * U.stride; kreg = *(const u32x4*)(kg + go); vreg = *(const u32x4*)(vg + go); }
        __syncthreads();
        const bool need = (64 * t <= wq_hi) && (64 * t + 63 >= wq_lo - U.window);
        if (need) {
            const LAS unsigned char* kb = kp0 + cur * 8192;
            f32x16 p0, p1;
#pragma unroll
            for (int r = 0; r < 16; ++r) { p0[r] = 0.f; p1[r] = 0.f; }
#pragma unroll
            for (int d0 = 0; d0 < 4; ++d0) {
                const bf16x8 b0 = *(const LAS bf16x8*)(kb + d0 * 2048), b1 = *(const LAS bf16x8*)(kb + d0 * 2048 + 512);
                p0 = __builtin_amdgcn_mfma_f32_32x32x16_bf16(b0, qr[d0], p0, 0, 0, 0);
                p1 = __builtin_amdgcn_mfma_f32_32x32x16_bf16(b1, qr[d0], p1, 0, 0, 0);
            }
            if (U.bias) {
#pragma unroll
                for (int g = 0; g < 4; ++g) {
                    const f32x4 c0 = *(const LAS f32x4*)(cumL + 64 * t + 8 * g + 4 * hi), c1 = *(const LAS f32x4*)(cumL + 64 * t + 32 + 8 * g + 4 * hi);
#pragma unroll
                    for (int e = 0; e < 4; ++e) { p0[4 * g + e] += c0[e]; p1[4 * g + e] += c1[e]; }
                }
            }
            const bool need_mask = (64 * t + 63 > wq_lo) || (64 * t < wq_hi - U.window);
            if (need_mask) {
                const int lo_ok = uq - U.window;
#pragma unroll
                for (int r = 0; r < 16; ++r) {
                    const int kv = 64 * t + crow(r, hi);
                    if (kv > uq || kv < lo_ok) p0[r] = -INFINITY;
                    if (kv + 32 > uq || kv + 32 < lo_ok) p1[r] = -INFINITY;
                }
            }
            float mx = fmaxf(p0[0], p1[0]);
#pragma unroll
            for (int r = 1; r < 16; ++r) mx = fmaxf(mx, fmaxf(p0[r], p1[r]));
            mx = fmaxf(mx, __shfl_xor(mx, 32));
            const float mn = fmaxf(m, mx);
            const float alpha = __builtin_amdgcn_exp2f(m - mn);
            m = mn;
            float rs = 0.f;
#pragma unroll
            for (int r = 0; r < 16; ++r) { p0[r] = __builtin_amdgcn_exp2f(p0[r] - mn); p1[r] = __builtin_amdgcn_exp2f(p1[r] - mn); rs += p0[r] + p1[r]; }
            l = l * alpha + rs;
            if (hi == 0) wsf[r32] = alpha;
#pragma unroll
            for (int g = 0; g < 4; ++g) {
                const f32x4 a = *(const LAS f32x4*)(wsf + 8 * g + 4 * hi);
#pragma unroll
                for (int e = 0; e < 4; ++e) { o0[4 * g + e] *= a[e]; o1[4 * g + e] *= a[e]; }
            }
            u32x4 pw[4];
#pragma unroll
            for (int c = 0; c < 4; ++c) {
                pw[0][c] = cvtpk(p0[2 * c], p0[2 * c + 1]); pw[1][c] = cvtpk(p0[8 + 2 * c], p0[8 + 2 * c + 1]);
                pw[2][c] = cvtpk(p1[2 * c], p1[2 * c + 1]); pw[3][c] = cvtpk(p1[8 + 2 * c], p1[8 + 2 * c + 1]);
            }
            const LAS unsigned char* vp = vp0 + cur * 8192;
#pragma unroll
            for (int ks = 0; ks < 4; ++ks) {
                const s16x4 a0 = vtr(vp + ks * 1024), a1 = vtr(vp + ks * 1024 + 512), c0 = vtr(vp + 4096 + ks * 1024), c1 = vtr(vp + 4096 + ks * 1024 + 512);
                const bf16x8 pa = __builtin_bit_cast(bf16x8, pw[ks]);
                const bf16x8 v0 = (bf16x8){a0[0], a0[1], a0[2], a0[3], a1[0], a1[1], a1[2], a1[3]};
                const bf16x8 v1 = (bf16x8){c0[0], c0[1], c0[2], c0[3], c1[0], c1[1], c1[2], c1[3]};
                o0 = __builtin_amdgcn_mfma_f32_32x32x16_bf16(pa, v0, o0, 0, 0, 0);
                o1 = __builtin_amdgcn_mfma_f32_32x32x16_bf16(pa, v1, o1, 0, 0, 0);
            }
        }
        if (more) { *(LAS u32x4*)(lds + kst + (cur ^ 1) * 8192) = kreg; *(LAS u32x4*)(lds + vst + (cur ^ 1) * 8192) = vreg; }
    }
    l += __shfl_xor(l, 32);
    if (hi == 0) { wsf[32 + r32] = l; if (U.lse) U.lse[(long)uq * U.lse_stride] = m + __builtin_amdgcn_logf(l); }
    bf16_t* Ow = U.O + (long)(U.q0 + wid * 32) * U.stride;
#pragma unroll
    for (int g = 0; g < 4; ++g) {
        const f32x4 lv = *(const LAS f32x4*)(wsf + 32 + 8 * g + 4 * hi);
#pragma unroll
        for (int e = 0; e < 4; ++e) {
            const int r = 4 * g + e; const float rl = 1.0f / lv[e];
            bf16_t* op = Ow + (long)crow(r, hi) * U.stride + r32;
            const unsigned w0 = cvtpk(o0[r] * rl, 0.f), w1 = cvtpk(o1[r] * rl, 0.f);
            op[0] = (bf16_t)(w0 & 0xffffu); op[32] = (bf16_t)(w1 & 0xffffu);
        }
    }
}
#undef LAS
}
#define LAS __attribute__((address_space(3)))
typedef unsigned short bf16_t;
typedef float f32x4 __attribute__((ext_vector_type(4)));
typedef unsigned u32x4 __attribute__((ext_vector_type(4)));
typedef unsigned u32x2 __attribute__((ext_vector_type(2)));

constexpr int NB = 8, SEQ = 4096, DM = 1024, MT = NB * SEQ, FF = 2816, NH = 16, MODN = 9216;
constexpr int NTHREADS = 512, NWAVES = 8;
constexpr float LOG2E = 1.4426950408889634f;
constexpr size_t MiB = (size_t)1 << 20;
constexpr size_t WS_BAR = 0, WS_BAR_BYTES = 16384;
constexpr size_t WS_MOD = 1 * MiB, WS_COS = 3 * MiB, WS_SIN = 4 * MiB, WS_CUM = 5 * MiB, WS_CHT = 7 * MiB, WS_LSE = 8 * MiB;
constexpr size_t WS_W = 16 * MiB, FFN_BLK = (size_t)(2 * FF * DM + DM * FF) * 2, FFN_DOWN_OFF = (size_t)2 * FF * DM * 2;
constexpr size_t WS_FOXIN = WS_W + 8 * FFN_BLK, FOXIN_SZ = (size_t)3072 * DM * 2;
constexpr size_t WS_FOXOUT = WS_FOXIN + 2 * FOXIN_SZ, OUT_SZ = (size_t)DM * DM * 2;
constexpr size_t WS_DILIN = WS_FOXOUT + 2 * OUT_SZ, DILIN_SZ = (size_t)9216 * DM * 2;
constexpr size_t WS_DILOUT = WS_DILIN + 2 * DILIN_SZ;
constexpr size_t WS_H = WS_DILOUT + 2 * OUT_SZ;
constexpr size_t WS_BIG = WS_H + (size_t)MT * DM * 2;
constexpr size_t WS_END = WS_BIG + (size_t)(MT / 2) * 9216 * 2;
static_assert(WS_W + 8 * FFN_BLK == 148 * MiB && WS_H == 204 * MiB && WS_END == 556 * MiB, "workspace map");
constexpr int LDS_BYTES = 147456;

__device__ __forceinline__ unsigned f2bf(float f) { unsigned u = __builtin_bit_cast(unsigned, f); return (u + 0x7fffu + ((u >> 16) & 1u)) >> 16; }
__device__ __forceinline__ unsigned pk2(float lo, float hi) { return f2bf(lo) | (f2bf(hi) << 16); }
__device__ __forceinline__ float bflo(unsigned w) { return __builtin_bit_cast(float, w << 16); }
__device__ __forceinline__ float bfhi(unsigned w) { return __builtin_bit_cast(float, w & 0xffff0000u); }
__device__ __forceinline__ float wave_sum(float v) {
#pragma unroll
    for (int o = 1; o < 64; o <<= 1) v += __shfl_xor(v, o);
    return v;
}

__device__ __forceinline__ int fresh_tid() { int t = threadIdx.x; asm volatile("" : "+v"(t)); return t; }
struct Args { const void* in[18]; float* out; unsigned char* ws; int ph_lo, ph_hi; };

__device__ __forceinline__ int map_row(int kind, int n0) {
    if (kind == 0) return n0;
    if (kind == 1) return 256 * (n0 >> 7) + (n0 & 127);
    if (kind == 2) return 256 * (n0 >> 7) + 128 + (n0 & 127);
    return (n0 & ~255) + 128 * ((n0 >> 5) & 1) + 32 * ((n0 >> 6) & 3);
}
__device__ __forceinline__ void conv_item(const float* W, int K, int Npitch, int nblk, bf16_t* WT, int kind, LAS float* scr, int item, int lane) {
    const int kb = item / nblk, nb = item % nblk, k0 = 64 * kb, n0 = 32 * nb;
    const int drow0 = map_row(kind, n0);
#pragma unroll 8
    for (int i = 0; i < 32; ++i) { const int kk = 2 * i + (lane >> 5); scr[kk * 33 + (lane & 31)] = W[(size_t)(k0 + kk) * Npitch + n0 + (lane & 31)]; }
    asm volatile("s_waitcnt lgkmcnt(0)" ::: "memory");
    const int c = lane & 7;
#pragma unroll
    for (int j = 0; j < 4; ++j) { const int n = (lane >> 3) + 8 * j; const LAS float* s = scr + (8 * c) * 33 + n;
        u32x4 o; o.x = pk2(s[0 * 33], s[1 * 33]); o.y = pk2(s[2 * 33], s[3 * 33]); o.z = pk2(s[4 * 33], s[5 * 33]); o.w = pk2(s[6 * 33], s[7 * 33]);
        *(u32x4*)(WT + (size_t)(drow0 + n) * K + k0 + 8 * c) = o; }
    asm volatile("s_waitcnt lgkmcnt(0)" ::: "memory");
}

template <class AT> __device__ __forceinline__ void prologue_phase(AT& a, LAS unsigned char* lds) {
    const int tid = fresh_tid(), lane = tid & 63, wid = __builtin_amdgcn_readfirstlane(tid >> 6);
    const int G = gridDim.x, bid = blockIdx.x;
    unsigned char* ws = a.ws;
    {
        const float* c = (const float*)a.in[1]; const float* mod_w = (const float*)a.in[3]; const float* mod_b = (const float*)a.in[4];
        float* modbuf = (float*)(ws + WS_MOD);
        LAS float* cact = (LAS float*)lds;
        LAS float* red = (LAS float*)(lds + 32768);
        for (int e = tid; e < NB * DM; e += NTHREADS) { const int b = e >> 10, k = e & 1023; const float v = c[e]; cact[k * 8 + b] = v / (1.0f + __expf(-v)); }
        __syncthreads();
        for (int task = bid; task < 4 * 144; task += G) {
            const int i = task / 144, n0 = (task % 144) * 64, n = n0 + lane;
            float acc[8];
#pragma unroll
            for (int b = 0; b < 8; ++b) acc[b] = 0.f;
            const float* wp = mod_w + ((size_t)i * DM + 128 * wid) * MODN + n;
#pragma unroll 4
            for (int kk = 0; kk < 128; ++kk) {
                const float wv = wp[(size_t)kk * MODN];
                const f32x4 c0 = *(const LAS f32x4*)(cact + (128 * wid + kk) * 8), c1 = *(const LAS f32x4*)(cact + (128 * wid + kk) * 8 + 4);
                acc[0] += c0[0] * wv; acc[1] += c0[1] * wv; acc[2] += c0[2] * wv; acc[3] += c0[3] * wv;
                acc[4] += c1[0] * wv; acc[5] += c1[1] * wv; acc[6] += c1[2] * wv; acc[7] += c1[3] * wv;
            }
#pragma unroll
            for (int b = 0; b < 8; ++b) red[(wid * 8 + b) * 64 + lane] = acc[b];
            __syncthreads();
            {
                const int b = tid >> 6; float s = 0.f;
#pragma unroll
                for (int w = 0; w < 8; ++w) s += red[(w * 8 + b) * 64 + lane];
                s += mod_b[(size_t)i * MODN + n];
                const int sidx = n / 3072, j = (n >> 10) % 3;
                if (j == 1) s += 1.0f;
                if (j == 2 && sidx != 1) s *= 0.5f;
                modbuf[((size_t)i * NB + b) * MODN + n] = s;
            }
            __syncthreads();
        }
    }
    __syncthreads();
    {
        const int* pos = (const int*)a.in[2];
        float* cs = (float*)(ws + WS_COS); float* sn = (float*)(ws + WS_SIN);
        for (int e = bid * NTHREADS + tid; e < MT * 8; e += G * NTHREADS) {
            const int i = e & 7;
            const float invf = (i == 0) ? 1.0f : (i == 1) ? 0.1939227432012558f : (i == 2) ? 0.03760603070259094f : (i == 3) ? 0.007292664609849453f
                             : (i == 4) ? 0.0014142135623842478f : (i == 5) ? 0.00027424818836152554f : (i == 6) ? 5.3182957344688475e-05f : 1.0313385246263351e-05f;
            const float ang = (float)pos[e >> 3] * invf;
            const double rev = (double)ang * 0.15915494309189535;
            const float fr = (float)(rev - floor(rev));
            cs[e] = __builtin_amdgcn_cosf(fr); sn[e] = __builtin_amdgcn_sinf(fr);
        }
    }
    {
        LAS float* scr = (LAS float*)(lds + wid * 16384);
        const float* wg = (const float*)a.in[6]; const float* wu = (const float*)a.in[7]; const float* wd = (const float*)a.in[8];
        const float* fin = (const float*)a.in[9]; const float* fout = (const float*)a.in[13];
        const float* din = (const float*)a.in[14]; const float* dout = (const float*)a.in[17];
        const int gw = bid * NWAVES + wid, NGW = G * NWAVES;
        constexpr int I_FFN = 1408, I_FIN = 1536, I_OUT = 512, I_DIN = 4608;
        constexpr int NITEMS = 8 * 3 * I_FFN + 2 * I_FIN + 2 * I_OUT + 2 * I_DIN + 2 * I_OUT;
        for (int it = gw; it < NITEMS; it += NGW) {
            int r = it;
            if (r < 8 * 3 * I_FFN) {
                const int f = r / (3 * I_FFN); r -= f * 3 * I_FFN; const int w3 = r / I_FFN; r -= w3 * I_FFN;
                bf16_t* gu = (bf16_t*)(ws + WS_W + (size_t)f * FFN_BLK);
                if (w3 == 0) conv_item(wg + (size_t)f * DM * FF, DM, FF, FF / 32, gu, 1, scr, r, lane);
                else if (w3 == 1) conv_item(wu + (size_t)f * DM * FF, DM, FF, FF / 32, gu, 2, scr, r, lane);
                else conv_item(wd + (size_t)f * FF * DM, FF, DM, DM / 32, (bf16_t*)(ws + WS_W + (size_t)f * FFN_BLK + FFN_DOWN_OFF), 0, scr, r, lane);
                continue;
            }
            r -= 8 * 3 * I_FFN;
            if (r < 2 * I_FIN) { const int j = r / I_FIN; r -= j * I_FIN; conv_item(fin + (size_t)j * DM * 3088, DM, 3088, 96, (bf16_t*)(ws + WS_FOXIN + (size_t)j * FOXIN_SZ), 3, scr, r, lane); continue; }
            r -= 2 * I_FIN;
            if (r < 2 * I_OUT) { const int j = r / I_OUT; r -= j * I_OUT; conv_item(fout + (size_t)j * DM * DM, DM, DM, 32, (bf16_t*)(ws + WS_FOXOUT + (size_t)j * OUT_SZ), 0, scr, r, lane); continue; }
            r -= 2 * I_OUT;
            if (r < 2 * I_DIN) { const int j = r / I_DIN; r -= j * I_DIN; conv_item(din + (size_t)j * DM * 9216, DM, 9216, 288, (bf16_t*)(ws + WS_DILIN + (size_t)j * DILIN_SZ), 3, scr, r, lane); continue; }
            r -= 2 * I_DIN;
            { const int j = r / I_OUT; r -= j * I_OUT; conv_item(dout + (size_t)j * DM * DM, DM, DM, 32, (bf16_t*)(ws + WS_DILOUT + (size_t)j * OUT_SZ), 0, scr, r, lane); }
        }
    }
}

template <bool FOX>
__device__ __forceinline__ void norm_phase(LAS unsigned char* lds, const float* xin, const float* g, const float* sc1p, const float* shift, bf16_t* hout,
                                           const float* wf_src, const float* bfv, float* cumloc, float* chtot) {
    const int tid = fresh_tid(), lane = tid & 63, wid = __builtin_amdgcn_readfirstlane(tid >> 6);
    const int G = gridDim.x;
    LAS float* wfL = (LAS float*)lds;
    if (FOX) {
        for (int k = tid; k < DM; k += NTHREADS) {
            const float* src = wf_src + (size_t)k * 3088;
#pragma unroll
            for (int q = 0; q < 4; ++q) { const f32x4 v = *(const f32x4*)(src + 4 * q);
#pragma unroll
                for (int e = 0; e < 4; ++e) wfL[(4 * q + e) * DM + k] = v[e]; }
        }
        __syncthreads();
    }
    for (int chunk = blockIdx.x; chunk < MT / 128; chunk += G) {
        const int b = chunk >> 5;
        const int row_base = chunk * 128 + wid * 16;
        f32x4 A[4], Bc[4];
#pragma unroll
        for (int j = 0; j < 4; ++j) {
            const int col = 4 * lane + 256 * j;
            A[j] = *(const f32x4*)(g + col) * *(const f32x4*)(sc1p + (size_t)b * MODN + col);
            Bc[j] = *(const f32x4*)(shift + (size_t)b * MODN + col);
        }
        float run = 0.f;
#pragma unroll 1
        for (int rg = 0; rg < 4; ++rg) {
            f32x4 hv[4][4];
#pragma unroll
            for (int rr = 0; rr < 4; ++rr) {
                const float* xr = xin + (size_t)(row_base + rg * 4 + rr) * DM + 4 * lane;
#pragma unroll
                for (int j = 0; j < 4; ++j) hv[rr][j] = *(const f32x4*)(xr + 256 * j);
            }
#pragma unroll
            for (int rr = 0; rr < 4; ++rr) {
                float ss = 0.f;
#pragma unroll
                for (int j = 0; j < 4; ++j) { const f32x4 t = hv[rr][j] * hv[rr][j]; ss += (t[0] + t[1]) + (t[2] + t[3]); }
                ss = wave_sum(ss);
                const float rstd = 1.0f / sqrtf(ss * (1.0f / DM) + 1e-6f);
                bf16_t* orow = hout + (size_t)(row_base + rg * 4 + rr) * DM + 4 * lane;
#pragma unroll
                for (int j = 0; j < 4; ++j) {
                    hv[rr][j] = hv[rr][j] * rstd * A[j] + Bc[j];
                    u32x2 w; w.x = pk2(hv[rr][j][0], hv[rr][j][1]); w.y = pk2(hv[rr][j][2], hv[rr][j][3]);
                    *(u32x2*)(orow + 256 * j) = w;
                }
            }
            if (FOX) {
                float zs[4] = {0.f, 0.f, 0.f, 0.f};
#pragma unroll 1
                for (int hh = 0; hh < 16; ++hh) {
                    f32x4 wv[4];
#pragma unroll
                    for (int j = 0; j < 4; ++j) wv[j] = *(const LAS f32x4*)(wfL + hh * DM + 4 * lane + 256 * j);
#pragma unroll
                    for (int rr = 0; rr < 4; ++rr) {
                        float s = 0.f;
#pragma unroll
                        for (int j = 0; j < 4; ++j) { const f32x4 t = hv[rr][j] * wv[j]; s += (t[0] + t[1]) + (t[2] + t[3]); }
                        s = wave_sum(s);
                        zs[rr] = ((lane & 15) == hh) ? s : zs[rr];
                    }
                }
                const float bfl = bfv[lane & 15];
                float* cp = cumloc + ((size_t)(b * NH + (lane & 15))) * SEQ + (chunk & 31) * 128 + wid * 16 + rg * 4;
#pragma unroll
                for (int rr = 0; rr < 4; ++rr) {
                    const float z = zs[rr] + bfl;
                    const float ls = -(fmaxf(-z, 0.f) + log1pf(__expf(-fabsf(z))));
                    run += ls;
                    if (lane < 16) cp[rr] = run;
                }
            }
        }
        if (FOX) { if (lane < 16) chtot[(b * NH + lane) * 256 + (chunk & 31) * 8 + wid] = run; }
    }
}

__device__ __forceinline__ void merge_phase(const bf16_t* qkv, const float* lse, bf16_t* hout) {
    const int tid = fresh_tid(), lane = tid & 63, wid = tid >> 6;
    const int gw = blockIdx.x * NWAVES + wid, NGW = gridDim.x * NWAVES;
    const int head = lane >> 2;
    for (int row = gw; row < MT / 2; row += NGW) {
        float ls[3], w[3];
#pragma unroll
        for (int g = 0; g < 3; ++g) ls[g] = lse[((size_t)row * 3 + g) * NH + head];
        const float mx = fmaxf(ls[0], fmaxf(ls[1], ls[2]));
        float sw = 0.f;
#pragma unroll
        for (int g = 0; g < 3; ++g) { w[g] = __builtin_amdgcn_exp2f(ls[g] - mx); sw += w[g]; }
        const float inv = 1.0f / sw;
        float acc[16];
#pragma unroll
        for (int e = 0; e < 16; ++e) acc[e] = 0.f;
#pragma unroll
        for (int g = 0; g < 3; ++g) {
            const u32x4* p = (const u32x4*)(qkv + (size_t)row * 9216 + g * 3072 + 16 * lane);
            const u32x4 v0 = p[0], v1 = p[1]; const float wg = w[g] * inv;
#pragma unroll
            for (int e = 0; e < 4; ++e) { acc[2 * e] += wg * bflo(v0[e]); acc[2 * e + 1] += wg * bfhi(v0[e]); acc[8 + 2 * e] += wg * bflo(v1[e]); acc[8 + 2 * e + 1] += wg * bfhi(v1[e]); }
        }
        u32x4 o0, o1;
#pragma unroll
        for (int e = 0; e < 4; ++e) { o0[e] = pk2(acc[2 * e], acc[2 * e + 1]); o1[e] = pk2(acc[8 + 2 * e], acc[8 + 2 * e + 1]); }
        u32x4* op = (u32x4*)(hout + (size_t)row * DM + 16 * lane);
        op[0] = o0; op[1] = o1;
    }
}

__device__ __forceinline__ void fox_attn_phase(LAS unsigned char* lds, bf16_t* Qb, const bf16_t* Kb, const bf16_t* Vb, const float* cumloc, const float* chtot) {
    const int tid = fresh_tid(), lane = tid & 63;
    const int G = gridDim.x;
    LAS float* cumL = (LAS float*)(lds + att::CUM_OFF);
    LAS float* pfL = (LAS float*)(lds + att::PF_OFF);
    LAS float* wtL = (LAS float*)(lds + att::PF_OFF + 1024);
    for (int i = 0;; ++i) {
        const int id = i * G + blockIdx.x; if (id >= NB * NH * 16) break;
        const int bh = id & 127, jj = id >> 7, qb = jj ^ ((jj >> 1) & 1);
        __syncthreads();
        {
            float v = (tid < 256) ? chtot[bh * 256 + tid] : 0.f; const float own = v;
#pragma unroll
            for (int off = 1; off < 64; off <<= 1) { const float t = __shfl_up(v, off); if (lane >= off) v += t; }
            if (lane == 63 && tid < 256) wtL[tid >> 6] = v;
            __syncthreads();
            float pre = 0.f;
            for (int w = 0; w < (tid >> 6); ++w) pre += (w < 4) ? wtL[w] : 0.f;
            if (tid < 256) pfL[tid] = v - own + pre;
        }
        __syncthreads();
        const int nk = qb * 256 + 256;
        for (int s = tid; s < nk; s += NTHREADS) cumL[s] = -(cumloc[(size_t)bh * SEQ + s] + pfL[s >> 4]) * LOG2E;
        att::Unit U;
        const size_t base = (size_t)(bh >> 4) * SEQ * DM + (size_t)(bh & 15) * 64;
        U.Q = Qb + base; U.K = Kb + base; U.V = Vb + base; U.O = Qb + base; U.stride = DM;
        U.q0 = qb * 256; U.t_lo = 0; U.t_hi = 4 * qb + 4; U.window = 1 << 30; U.bias = 1; U.lse = nullptr; U.lse_stride = 0;
        att::unit_run(lds, U);
    }
}
__device__ __forceinline__ void dil_attn_phase(LAS unsigned char* lds, bf16_t* qkv, float* lse) {
    const int G = gridDim.x;
    for (int i = 0;; ++i) {
        const int id = i * G + blockIdx.x; if (id >= 4 * NH * 48) break;
        const int sub = id & 15, g = (id >> 4) % 3, h = (id / 48) & 15, bl = id / 768;
        int d, rho, blk;
        if (g == 0) { d = 1; rho = 0; blk = sub; } else if (g == 1) { d = 4; rho = sub >> 2; blk = sub & 3; } else { d = 16; rho = sub; blk = 0; }
        __syncthreads();
        att::Unit U;
        const size_t rowl = (size_t)bl * SEQ + rho;
        bf16_t* qp = qkv + rowl * 9216 + (size_t)g * 3072 + h * 64;
        U.Q = qp; U.K = qp + 1024; U.V = qp + 2048; U.O = qp; U.stride = (long)d * 9216;
        U.q0 = blk * 256; U.t_lo = (4 * blk - 2 > 0) ? 4 * blk - 2 : 0; U.t_hi = 4 * blk + 4; U.window = 128; U.bias = 0;
        U.lse = lse + (rowl * 3 + g) * NH + h; U.lse_stride = (long)d * 48;
        att::unit_run(lds, U);
    }
}

#define XB_TMO      128
#define XB_XCNT(j)  (256  + 64 * (j))
#define XB_XSUB(j)  (1280 + 64 * (j))
#define XB_XGEN(j)  (2304 + 64 * (j))
#define XB_TOP      3328
#define XB_TOPGEN   3392
#define XCD_BAR_WORDS 3456
#define XB_SPIN_CAP (1u << 18)

__device__ __forceinline__ unsigned xb_ld(unsigned* p)              { return __hip_atomic_load(p, __ATOMIC_RELAXED, __HIP_MEMORY_SCOPE_AGENT); }
__device__ __forceinline__ unsigned xb_add(unsigned* p, unsigned v) { return __hip_atomic_fetch_add(p, v, __ATOMIC_RELAXED, __HIP_MEMORY_SCOPE_AGENT); }
__device__ __forceinline__ unsigned xb_xcc_id() { return (unsigned)__builtin_amdgcn_s_getreg((3 << 11) | 20) & 0xFu; }
#define XB_SPIN(cond, bar) do { unsigned _sp = 0; while (cond) { __builtin_amdgcn_s_sleep(1); \
    if ((++_sp & 255u) == 0u) { if (xb_ld(&(bar)[XB_TMO])) break; if (_sp > XB_SPIN_CAP) { atomicAdd(&(bar)[XB_TMO], 1u); break; } } } } while (0)

struct XcdBarrier {
    unsigned* bar; unsigned x;
    volatile LAS unsigned* st;
};

__device__ __forceinline__ XcdBarrier xcd_barrier_post(unsigned* bar, volatile LAS unsigned* st) {
    XcdBarrier b; b.bar = bar; b.x = xb_xcc_id(); b.st = st;
    if (threadIdx.x == 0) (void)xb_add(&bar[XB_XCNT(b.x)], 1u);
    return b;
}
__device__ __forceinline__ void xcd_barrier_complete(unsigned* bar, unsigned x, unsigned& nloc, unsigned& nx) {
    const unsigned G = gridDim.x * gridDim.y * gridDim.z;
    unsigned sum, cnt, mine, sp = 0u;
    for (;;) {
        sum = 0u; cnt = 0u; mine = 0u;
#pragma unroll
        for (unsigned j = 0; j < 16; ++j) { const unsigned c = xb_ld(&bar[XB_XCNT(j)]); sum += c; cnt += (c > 0u) ? 1u : 0u; mine = (j == x) ? c : mine; }
        if (sum == G) break;
        __builtin_amdgcn_s_sleep(1);
        if ((++sp & 255u) == 0u) { if (xb_ld(&bar[XB_TMO])) break; if (sp > XB_SPIN_CAP) { atomicAdd(&bar[XB_TMO], 1u); break; } }
    }
    nloc = mine > 0u ? mine : 1u; nx = cnt > 0u ? cnt : 1u;
}

__device__ __forceinline__ void xcd_barrier(const XcdBarrier& b) {
    asm volatile("s_waitcnt vmcnt(0)" ::: "memory");
    __syncthreads();
    if (threadIdx.x == 0) {
        unsigned* bar = b.bar;
        __builtin_amdgcn_s_waitcnt(0);
        unsigned nloc = b.st[0], nx = b.st[1];
        if (nloc == 0u) { xcd_barrier_complete(bar, b.x, nloc, nx); b.st[0] = nloc; b.st[1] = nx; }
        const unsigned old = xb_add(&bar[XB_XSUB(b.x)], 1u);
        const unsigned gen = old / nloc;
        if (old + 1u == (gen + 1u) * nloc) {
            __builtin_amdgcn_fence(__ATOMIC_RELEASE, "agent");
            asm volatile("s_waitcnt vmcnt(0)" ::: "memory");
            const unsigned og = xb_add(&bar[XB_TOP], 1u);
            const unsigned tg = og / nx;
            if (og + 1u == (tg + 1u) * nx) xb_add(&bar[XB_TOPGEN], 1u);
            else XB_SPIN(xb_ld(&bar[XB_TOPGEN]) == tg, bar);
            __builtin_amdgcn_fence(__ATOMIC_ACQUIRE, "agent");
            xb_add(&bar[XB_XGEN(b.x)], 1u);
            asm volatile("s_waitcnt vmcnt(0)" ::: "memory");
        } else {
            XB_SPIN(xb_ld(&bar[XB_XGEN(b.x)]) == gen, bar);
            __builtin_amdgcn_fence(__ATOMIC_ACQUIRE, "agent");
            asm volatile("s_waitcnt vmcnt(0)" ::: "memory");
        }
    }
    __syncthreads();
}

#ifndef PMASK
#define PMASK 255
#endif
enum { OP_NORM = 0, OP_GU = 1, OP_DOWN = 2, OP_QKV = 3, OP_ATT = 4, OP_OUT = 5, OP_PROJ = 6, OP_DATT = 7, OP_MERGE = 8 };
constexpr int N_PHASES = 1 + 2 * 10 + 2 * 14;

typedef const Args __attribute__((address_space(4))) CArgs;
__device__ __forceinline__ CArgs& fresh_args() { unsigned long long p = (unsigned long long)__builtin_amdgcn_kernarg_segment_ptr(); asm volatile("" : "+s"(p)); return *(CArgs*)p; }
__device__ __forceinline__ void run_phase(LAS unsigned char* lds, int ph) {
    CArgs& a = fresh_args();
    if (ph == 0) { if (PMASK & 1) prologue_phase(a, lds); return; }
    int p = ph - 1, layer = 0, n;
    for (;;) { n = (layer & 1) ? 14 : 10; if (p < n) break; p -= n; ++layer; }
    const bool dil = (layer & 1) != 0; const int j = layer >> 1;
    int op, sub, hb = 0, ffn = 0;
    if (p < 3) { sub = 0; ffn = 0; op = p; }
    else if (p >= n - 3) { sub = 2; ffn = 1; op = p - (n - 3); }
    else { sub = 1; const int q = p - 3;
        if (!dil) op = (q == 0) ? OP_NORM : (q == 1) ? OP_QKV : (q == 2) ? OP_ATT : OP_OUT;
        else if (q == 0) op = OP_NORM; else if (q == 7) op = OP_OUT; else { hb = (q - 1) / 3; const int r = (q - 1) % 3; op = (r == 0) ? OP_PROJ : (r == 1) ? OP_DATT : OP_MERGE; } }
    unsigned char* ws = a.ws;
    const float* x0 = (const float*)a.in[0];
    float* xo = a.out;
    const bool first = (layer == 0 && sub == 0);
    const float* xin = first ? x0 : (const float*)xo;
    const float* modl = (const float*)(ws + WS_MOD) + (size_t)layer * NB * MODN + (size_t)sub * 3 * DM;
    bf16_t* HB = (bf16_t*)(ws + WS_H);
    bf16_t* BIG = (bf16_t*)(ws + WS_BIG);
    const int G = gridDim.x, bid = blockIdx.x;
    const int f = layer * 2 + ffn;
    if (op == OP_NORM && (PMASK & 2)) {
        const float* g = (const float*)a.in[5] + (size_t)(layer * 3 + sub) * DM;
        if (sub == 1 && !dil)
            norm_phase<true>(lds, xin, g, modl + DM, modl, HB, (const float*)a.in[9] + (size_t)j * DM * 3088 + 3072, (const float*)a.in[10] + j * NH, (float*)(ws + WS_CUM), (float*)(ws + WS_CHT));
        else
            norm_phase<false>(lds, xin, g, modl + DM, modl, HB, nullptr, nullptr, nullptr, nullptr);
    } else if ((op == OP_GU || op == OP_DOWN || op == OP_OUT || op == OP_QKV || op == OP_PROJ) && (PMASK & 4)) {
        pg8::Gemm gm; pg8::StaticOrder S; pg8::EpiAny E;
        E.kind = 0; E.s.Hd = BIG; E.r.xin = xin; E.r.xout = xo; E.r.coef = modl + 2 * DM;
        E.q.out = BIG; E.q.fox = 1; E.q.qg = nullptr; E.q.kg = nullptr; E.q.cs = nullptr; E.q.sn = nullptr;
        if (op == OP_GU) { gm = pg8::Gemm{HB, (const bf16_t*)(ws + WS_W + (size_t)f * FFN_BLK), MT, 2 * FF, DM}; E.kind = 0; }
        else if (op == OP_DOWN) { gm = pg8::Gemm{BIG, (const bf16_t*)(ws + WS_W + (size_t)f * FFN_BLK + FFN_DOWN_OFF), MT, DM, FF}; E.kind = 1; }
        else if (op == OP_OUT) { E.kind = 1;
            if (!dil) gm = pg8::Gemm{BIG, (const bf16_t*)(ws + WS_FOXOUT + (size_t)j * OUT_SZ), MT, DM, DM};
            else gm = pg8::Gemm{HB, (const bf16_t*)(ws + WS_DILOUT + (size_t)j * OUT_SZ), MT, DM, DM}; }
        else if (op == OP_QKV) { E.kind = 2;
            gm = pg8::Gemm{HB, (const bf16_t*)(ws + WS_FOXIN + (size_t)j * FOXIN_SZ), MT, 3072, DM};
            E.q.qg = (const float*)a.in[11] + j * 64; E.q.kg = (const float*)a.in[12] + j * 64; }
        else { E.kind = 2; E.q.fox = 0;
            gm = pg8::Gemm{HB + (size_t)hb * (MT / 2) * DM, (const bf16_t*)(ws + WS_DILIN + (size_t)j * DILIN_SZ), MT / 2, 9216, DM};
            E.q.qg = (const float*)a.in[15] + j * 192; E.q.kg = (const float*)a.in[16] + j * 192;
            E.q.cs = (const float*)(ws + WS_COS) + (size_t)hb * (MT / 2) * 8; E.q.sn = (const float*)(ws + WS_SIN) + (size_t)hb * (MT / 2) * 8; }
        S.init(gm.M, gm.N, G, bid);
        pg8::gemm_phase<pg8::EpiAny, pg8::StaticOrder, true, true>(lds, gm, S, E);
    } else if (op == OP_ATT && (PMASK & 32)) {
        fox_attn_phase(lds, BIG, BIG + (size_t)MT * DM, BIG + (size_t)2 * MT * DM, (const float*)(ws + WS_CUM), (const float*)(ws + WS_CHT));
    } else if (op == OP_DATT && (PMASK & 64)) {
        dil_attn_phase(lds, BIG, (float*)(ws + WS_LSE));
    } else if (op == OP_MERGE && (PMASK & 128)) {
        merge_phase(BIG, (const float*)(ws + WS_LSE), HB + (size_t)hb * (MT / 2) * DM);
    }
}

#ifndef REP_MASK
#define REP_MASK 0
#endif
#ifndef SYNC_REP
#define SYNC_REP 1
#endif
__device__ __forceinline__ int phase_op(int ph) {
    if (ph == 0) return 9;
    int p = ph - 1, layer = 0, n;
    for (;;) { n = (layer & 1) ? 14 : 10; if (p < n) break; p -= n; ++layer; }
    if (p < 3) return p;
    if (p >= n - 3) return p - (n - 3);
    const int q = p - 3;
    if (!(layer & 1)) return (q == 0) ? OP_NORM : (q == 1) ? OP_QKV : (q == 2) ? OP_ATT : OP_OUT;
    if (q == 0) return OP_NORM; if (q == 7) return OP_OUT;
    const int r = (q - 1) % 3; return (r == 0) ? OP_PROJ : (r == 1) ? OP_DATT : OP_MERGE;
}
#ifndef MK_COOP
#define MK_COOP 1
#endif

__global__ void __launch_bounds__(NTHREADS, 2) mk_fwd(Args a) {
    extern __shared__ __attribute__((aligned(16))) unsigned char lds_raw[];
    LAS unsigned char* lds = (LAS unsigned char*)lds_raw;
    volatile LAS unsigned* misc = (volatile LAS unsigned*)(lds + LDS_BYTES - 64);
    if (threadIdx.x < 16) misc[threadIdx.x] = 0u;
    __syncthreads();
    XcdBarrier bar = xcd_barrier_post((unsigned*)(fresh_args().ws + WS_BAR), misc);
    const int lo = fresh_args().ph_lo;
    for (int ph = lo;; ++ph) {
#if REP_MASK
        const int nrep = ((REP_MASK >> phase_op(ph)) & 1) ? 2 : 1;
        for (int rep = 0; rep < nrep; ++rep) { run_phase(lds, ph); __syncthreads(); }
#else
        run_phase(lds, ph);
#endif
        if (ph + 1 >= fresh_args().ph_hi) break;
        for (int sr = 0; sr < SYNC_REP; ++sr) { if (ph == lo) cg::this_grid().sync(); else xcd_barrier(bar); }
    }
}

extern "C" void kernel_launch(void* const* d_in, const int* in_sizes, int n_in, void* d_out, int out_size, void* d_ws, size_t ws_size, hipStream_t stream) {
    static int grid = 0;
    if (grid == 0) {
        if (n_in != 18 || out_size != MT * DM || ws_size < WS_END) { fprintf(stderr, "kernel_launch: unexpected shapes (n_in %d, out %d, ws %zu; need ws >= %zu)\n", n_in, out_size, ws_size, (size_t)WS_END); grid = -1; return; }
        int dev = 0, cus = 0, per_cu = 0;
        if (hipGetDevice(&dev) != hipSuccess || hipDeviceGetAttribute(&cus, hipDeviceAttributeMultiprocessorCount, dev) != hipSuccess) { grid = -1; return; }
        if (hipFuncSetAttribute((const void*)mk_fwd, hipFuncAttributeMaxDynamicSharedMemorySize, LDS_BYTES) != hipSuccess) { fprintf(stderr, "kernel_launch: hipFuncSetAttribute failed\n"); grid = -1; return; }
        if (hipOccupancyMaxActiveBlocksPerMultiprocessor(&per_cu, (const void*)mk_fwd, NTHREADS, LDS_BYTES) != hipSuccess || per_cu < 1) { per_cu = 1; (void)hipGetLastError(); }
        grid = cus * per_cu;
    }
    if (grid < 0) return;
    Args a{};
    for (int i = 0; i < 18; ++i) a.in[i] = d_in[i];
    a.out = (float*)d_out; a.ws = (unsigned char*)d_ws;
#if MK_COOP
    if (hipMemsetAsync((char*)d_ws + WS_BAR, 0, WS_BAR_BYTES, stream) != hipSuccess) { fprintf(stderr, "kernel_launch: memset failed\n"); return; }
    a.ph_lo = 0; a.ph_hi = N_PHASES;
    void* args[] = {&a};
    hipError_t e = hipLaunchCooperativeKernel((const void*)mk_fwd, dim3(grid), dim3(NTHREADS), args, LDS_BYTES, stream);
    if (e != hipSuccess) fprintf(stderr, "cooperative launch failed: %s (grid %d)\n", hipGetErrorString(e), grid);
#else
    for (int ph = 0; ph < N_PHASES; ++ph) {
        a.ph_lo = ph; a.ph_hi = ph + 1;
        hipLaunchKernelGGL(mk_fwd, dim3(grid), dim3(NTHREADS), LDS_BYTES, stream, a);
    }
#endif
}
```

```cpp
#include <hip/hip_runtime.h>
#include <hip/hip_cooperative_groups.h>
#include <hip/hip_bf16.h>
#include <cstdio>
#include <cstdint>
#include <cmath>
namespace cg = cooperative_groups;
namespace pg8 {
#define PG8_LAS __attribute__((address_space(3)))
typedef unsigned short bf16_t;
typedef short bf16x8 __attribute__((ext_vector_type(8)));
typedef float f32x4 __attribute__((ext_vector_type(4)));
typedef unsigned u32x4 __attribute__((ext_vector_type(4)));
constexpr int BM = 256, BK = 64, HALF = 128, HTB = HALF * BK * 2  , STAGE_BYTES = 8 * HTB, NXCD = 8, WGM = 8;

__host__ __device__ __forceinline__ int lds_byte(int r, int c) { const int st = (r >> 4) * 2 + (c >> 5), rr = r & 15, cc = c & 31, ob = rr * 64 + cc * 2; return st * 1024 + (ob ^ (((ob >> 9) & 1) << 5)); }
__host__ __device__ __forceinline__ void stage_rc(int b, int& R, int& C) { const int st = b / 1024, sb = b % 1024, swz = sb ^ (((sb >> 9) & 1) << 5); R = (st >> 1) * 16 + swz / 64; C = (st & 1) * 32 + (swz % 64) / 2; }
__host__ __device__ __forceinline__ int perm32(int rho) { const int n = rho >> 4, i = rho & 15; return 8 * (i >> 2) + 4 * n + (i & 3); }

struct Unit { int pm, pn; };
struct Gemm { const bf16_t* A; const bf16_t* Bt; int M, N, K; };

struct StaticOrder {
    int nM, nN, nwg, G, c;
    __host__ __device__ void init(int M, int N, int G_, int c_) { nM = M / BM; nN = N / BM; nwg = nM * nN; G = G_; c = c_; }
    __host__ __device__ bool next(int i, Unit& u) const {
        const long L = (long)i * G + c; if (L >= nwg) return false;
        int wgid = (int)L; { const int q = nwg / NXCD, r = nwg % NXCD, xcd = wgid % NXCD, off = wgid / NXCD; wgid = (xcd < r ? xcd * (q + 1) : r * (q + 1) + (xcd - r) * q) + off; }
        const int nig = WGM * nN, gid = wgid / nig, fm = gid * WGM, gsz = (nM - fm) < WGM ? (nM - fm) : WGM;
        u.pm = fm + ((wgid % nig) % gsz); u.pn = (wgid % nig) / gsz; return true;
    }
    __device__ __forceinline__ void a_ready(const Unit&) const {}
    __device__ __forceinline__ void done(const Unit&) const {}
};

__device__ __forceinline__ unsigned cvt_pk_bf16(float lo, float hi) { unsigned r; asm volatile("v_cvt_pk_bf16_f32 %0, %1, %2" : "=v"(r) : "v"(lo), "v"(hi)); return r; }
typedef float f32x2 __attribute__((ext_vector_type(2)));
constexpr int P_MT = 32768, P_DM = 1024, P_FF = 2816, P_MODN = 9216;
constexpr float P_C2 = 0.125f * 1.4426950408889634f;

struct EpiSwiGLU {
    static constexpr bool PERM = true, AFTER_DRAIN = false;
    bf16_t* Hd;
    __device__ __forceinline__ void operator()(const f32x4 (&acc)[2][2][4][2], const Unit& u, int wr, int wc, int fr, int fq) const {
        const int row0 = u.pm * BM + wr * 64 + fr, col0 = u.pn * 128 + wc * 32 + 8 * fq;
#pragma unroll
        for (int ai = 0; ai < 2; ++ai)
#pragma unroll
            for (int m = 0; m < 4; ++m) {
                bf16_t* rowp = Hd + (size_t)(row0 + ai * HALF + m * 16) * P_FF + col0;
                float v[8];
#pragma unroll
                for (int n = 0; n < 2; ++n)
#pragma unroll
                    for (int e = 0; e < 4; ++e) {
                        const float g = acc[ai][0][m][n][e], up = acc[ai][1][m][n][e];
                        const float s = __builtin_amdgcn_rcpf(1.0f + __builtin_amdgcn_exp2f(-1.4426950408889634f * g));
                        v[n * 4 + e] = g * s * up;
                    }
                u32x4 w; w.x = cvt_pk_bf16(v[0], v[1]); w.y = cvt_pk_bf16(v[2], v[3]); w.z = cvt_pk_bf16(v[4], v[5]); w.w = cvt_pk_bf16(v[6], v[7]);
                *(u32x4*)rowp = w;
            }
    }
};

struct EpiResid {
    static constexpr bool PERM = true, AFTER_DRAIN = false;
    const float* xin; float* xout; const float* coef;
    __device__ __forceinline__ void operator()(const f32x4 (&acc)[2][2][4][2], const Unit& u, int wr, int wc, int fr, int fq) const {
        const int row0 = u.pm * BM + wr * 64 + fr, col0 = u.pn * BM + wc * 32 + 8 * fq;
        const float* cf = coef + (size_t)(u.pm >> 4) * P_MODN + col0;
        f32x4 cv[2][2];
#pragma unroll
        for (int bj = 0; bj < 2; ++bj)
#pragma unroll
            for (int n = 0; n < 2; ++n) cv[bj][n] = *(const f32x4*)(cf + bj * HALF + n * 4);
#pragma unroll
        for (int ai = 0; ai < 2; ++ai)
#pragma unroll
            for (int m = 0; m < 4; ++m) {
                const size_t off = (size_t)(row0 + ai * HALF + m * 16) * P_DM + col0;
#pragma unroll
                for (int bj = 0; bj < 2; ++bj)
#pragma unroll
                    for (int n = 0; n < 2; ++n) {
                        const f32x4 xi = *(const f32x4*)(xin + off + bj * HALF + n * 4);
                        *(f32x4*)(xout + off + bj * HALF + n * 4) = xi + cv[bj][n] * acc[ai][bj][m][n];
                    }
            }
    }
};

struct EpiQKV {
    static constexpr bool PERM = true, AFTER_DRAIN = false;
    bf16_t* out; int fox; const float* qg; const float* kg; const float* cs; const float* sn;
    __device__ __forceinline__ void operator()(const f32x4 (&acc)[2][2][4][2], const Unit& u, int wr, int wc, int fr, int fq) const {
        int which, colbase, pitch; bf16_t* base; const float* gq; const float* gk;
        if (fox) { which = u.pn >> 2; base = out + (size_t)which * ((size_t)P_MT * P_DM); pitch = P_DM; colbase = (u.pn & 3) * 256; gq = qg; gk = kg; }
        else { const int grp = u.pn / 12; which = (u.pn % 12) >> 2; base = out; pitch = 9216; colbase = u.pn * 256; gq = qg + grp * 64; gk = kg + grp * 64; }
        const int row0 = u.pm * BM + wr * 64 + fr;
        const int cw = colbase + wc * 64 + 8 * fq;
        if (which == 2) {
#pragma unroll
            for (int ai = 0; ai < 2; ++ai)
#pragma unroll
                for (int m = 0; m < 4; ++m) {
                    bf16_t* rowp = base + (size_t)(row0 + ai * HALF + m * 16) * pitch + cw;
#pragma unroll
                    for (int bj = 0; bj < 2; ++bj) {
                        const f32x4 v0 = acc[ai][bj][m][0], v1 = acc[ai][bj][m][1];
                        u32x4 w; w.x = cvt_pk_bf16(v0[0], v0[1]); w.y = cvt_pk_bf16(v0[2], v0[3]); w.z = cvt_pk_bf16(v1[0], v1[1]); w.w = cvt_pk_bf16(v1[2], v1[3]);
                        *(u32x4*)(rowp + bj * 32) = w;
                    }
                }
        } else {
            const float* gp = (which == 0) ? gq : gk; const float osc = (which == 0) ? P_C2 : 1.0f;
            f32x4 gv[2][2];
#pragma unroll
            for (int bj = 0; bj < 2; ++bj)
#pragma unroll
                for (int n = 0; n < 2; ++n) gv[bj][n] = *(const f32x4*)(gp + 32 * bj + 8 * fq + 4 * n) * osc;
#pragma unroll
            for (int ai = 0; ai < 2; ++ai)
#pragma unroll
                for (int m = 0; m < 4; ++m) {
                    const int row = row0 + ai * HALF + m * 16;
                    f32x4 v[2][2]; float ss = 0.f;
#pragma unroll
                    for (int bj = 0; bj < 2; ++bj)
#pragma unroll
                        for (int n = 0; n < 2; ++n) { v[bj][n] = acc[ai][bj][m][n]; const f32x4 t = v[bj][n] * v[bj][n]; ss += (t[0] + t[1]) + (t[2] + t[3]); }
                    ss += __shfl_xor(ss, 16); ss += __shfl_xor(ss, 32);
                    const float rstd = 1.0f / sqrtf(ss * (1.0f / 64.0f) + 1e-6f);
#pragma unroll
                    for (int bj = 0; bj < 2; ++bj)
#pragma unroll
                        for (int n = 0; n < 2; ++n) v[bj][n] = v[bj][n] * rstd * gv[bj][n];
                    if (!fox) {
#pragma unroll
                        for (int n = 0; n < 2; ++n) {
                            const f32x4 c = *(const f32x4*)(cs + (size_t)row * 8 + 4 * n), s = *(const f32x4*)(sn + (size_t)row * 8 + 4 * n);
                            f32x4 oth;
#pragma unroll
                            for (int e = 0; e < 4; ++e) oth[e] = __shfl_xor(v[0][n][e], 16);
                            const f32x4 r0 = v[0][n] * c - oth * s, r1 = v[0][n] * c + oth * s;
                            v[0][n] = (fq == 0) ? r0 : ((fq == 1) ? r1 : v[0][n]);
                        }
                    }
                    bf16_t* rowp = base + (size_t)row * pitch + cw;
#pragma unroll
                    for (int bj = 0; bj < 2; ++bj) {
                        const f32x4 v0 = v[bj][0], v1 = v[bj][1];
                        u32x4 w; w.x = cvt_pk_bf16(v0[0], v0[1]); w.y = cvt_pk_bf16(v0[2], v0[3]); w.z = cvt_pk_bf16(v1[0], v1[1]); w.w = cvt_pk_bf16(v1[2], v1[3]);
                        *(u32x4*)(rowp + bj * 32) = w;
                    }
                }
        }
    }
};

struct EpiAny {
    static constexpr bool PERM = true, AFTER_DRAIN = false;
    int kind; EpiSwiGLU s; EpiResid r; EpiQKV q;
    __device__ __forceinline__ void operator()(const f32x4 (&acc)[2][2][4][2], const Unit& u, int wr, int wc, int fr, int fq) const {
        if (kind == 0) s(acc, u, wr, wc, fr, fq); else if (kind == 1) r(acc, u, wr, wc, fr, fq); else if (kind == 2) q(acc, u, wr, wc, fr, fq);
    }
};
template <class Epi, class Sched, bool ALIGN_EPI = false, bool SP2 = false>
__device__ __forceinline__ void gemm_phase(PG8_LAS unsigned char* lds, const Gemm g, const Sched& S, const Epi& E) {
    int tid_ = threadIdx.x; asm volatile("" : "+v"(tid_)); const int tid = tid_, wid = __builtin_amdgcn_readfirstlane(tid >> 6), lane = tid & 63, wr = wid >> 2, wc = wid & 3, fr = lane & 15, fq = lane >> 4;
    const int K = g.K, nt = K / BK;
    unsigned voffA[2], voffB[2];
#pragma unroll
    for (int i = 0; i < 2; ++i) { int R, C; stage_rc(tid * 16 + i * 8192, R, C); const int Rb = Epi::PERM ? ((R & ~31) + perm32(R & 31)) : R;
        voffA[i] = (unsigned)(R * K + C) * 2u; voffB[i] = (unsigned)(Rb * K + C) * 2u; }
    const size_t kstep = (size_t)(BK * 2);
    const size_t hstep = (size_t)HALF * K * 2;
    const size_t tstep = 2 * hstep;
    const unsigned ldsw = (unsigned)wid * 1024u;
    const int aoff = lds_byte(wr * 64 + fr, fq * 8), boff = lds_byte(wc * 32 + fr, fq * 8);
#define PG8_SA(b, h) (((b) * 2 + (h)) * HTB)
#define PG8_SB(b, h) ((4 + (b) * 2 + (h)) * HTB)
#define PG8_STAGE(bufoff, gbase, voff) do { _Pragma("unroll") for (int _i = 0; _i < 2; ++_i) \
        __builtin_amdgcn_global_load_lds((const unsigned*)((const char*)(gbase) + (voff)[_i]), (PG8_LAS unsigned*)(lds + (bufoff) + ldsw + _i * 8192), 16, 0, 0); } while (0)
#define PG8_LDA(dst, b, h) do { _Pragma("unroll") for (int m = 0; m < 4; ++m) _Pragma("unroll") for (int k = 0; k < 2; ++k) dst[m][k] = *(const PG8_LAS bf16x8*)(lds + PG8_SA(b, h) + aoff + m * 2048 + k * 1024); } while (0)
#define PG8_LDB(dst, b, h) do { _Pragma("unroll") for (int n = 0; n < 2; ++n) _Pragma("unroll") for (int k = 0; k < 2; ++k) dst[n][k] = *(const PG8_LAS bf16x8*)(lds + PG8_SB(b, h) + boff + n * 2048 + k * 1024); } while (0)
#define PG8_MMA(ai, bj, At, Bt) do { __builtin_amdgcn_s_setprio(1); _Pragma("unroll") for (int m = 0; m < 4; ++m) _Pragma("unroll") for (int n = 0; n < 2; ++n) _Pragma("unroll") for (int k = 0; k < 2; ++k) \
        acc[ai][bj][m][n] = __builtin_amdgcn_mfma_f32_16x16x32_bf16(Bt[n][k], At[m][k], acc[ai][bj][m][n], 0, 0, 0); __builtin_amdgcn_s_setprio(0); } while (0)
#define PG8_WAIT_V(n) asm volatile("s_waitcnt vmcnt(" #n ")" ::: "memory")
#define PG8_WAIT_L(n) asm volatile("s_waitcnt lgkmcnt(" #n ")" ::: "memory")
#define PG8_BAR __builtin_amdgcn_s_barrier()
#define PG8_SCHED __builtin_amdgcn_sched_barrier(0)
    Unit cur, nxt; int ui = 0;
    if (!S.next(0, cur)) return;
    f32x4 acc[2][2][4][2];
#pragma unroll
    for (int a = 0; a < 2; ++a)
#pragma unroll
        for (int b = 0; b < 2; ++b)
#pragma unroll
            for (int m = 0; m < 4; ++m)
#pragma unroll
                for (int n = 0; n < 2; ++n) acc[a][b][m][n] = (f32x4){0.f, 0.f, 0.f, 0.f};
    bf16x8 At[4][2], B0[2][2], B1[2][2];
    const char* cA = (const char*)g.A + (size_t)cur.pm * tstep; const char* cB = (const char*)g.Bt + (size_t)cur.pn * tstep;
    S.a_ready(cur);
    if constexpr (SP2) {
        PG8_STAGE(PG8_SB(0, 0), cB, voffB); PG8_STAGE(PG8_SB(0, 1), cB + hstep, voffB); PG8_STAGE(PG8_SA(0, 0), cA, voffA); PG8_STAGE(PG8_SA(0, 1), cA + hstep, voffA);
        if (wr == 1) PG8_BAR;
        PG8_WAIT_V(2); PG8_BAR;
        PG8_STAGE(PG8_SB(1, 0), cB + kstep, voffB); PG8_STAGE(PG8_SA(1, 0), cA + kstep, voffA); PG8_STAGE(PG8_SB(1, 1), cB + hstep + kstep, voffB);
        PG8_WAIT_V(6); PG8_BAR;
    } else {
        PG8_STAGE(PG8_SB(0, 0), cB, voffB); PG8_STAGE(PG8_SA(0, 0), cA, voffA); PG8_STAGE(PG8_SB(0, 1), cB + hstep, voffB); PG8_STAGE(PG8_SA(0, 1), cA + hstep, voffA);
        if (wr == 1) PG8_BAR;
        PG8_WAIT_V(4); PG8_BAR;
        PG8_STAGE(PG8_SB(1, 0), cB + kstep, voffB); PG8_STAGE(PG8_SA(1, 0), cA + kstep, voffA); PG8_STAGE(PG8_SB(1, 1), cB + hstep + kstep, voffB);
        PG8_WAIT_V(6); PG8_BAR;
    }
    for (;;) {
        const bool has_next = S.next(ui + 1, nxt);
        const char* nA = has_next ? (const char*)g.A + (size_t)nxt.pm * tstep : cA; const char* nB = has_next ? (const char*)g.Bt + (size_t)nxt.pn * tstep : cB;
        for (int t = 0; t < nt; t += 2) {
            const bool last = (t == nt - 2);
            const char* a1 = cA + (size_t)(t + 1) * kstep;
            const char* a2 = last ? nA : cA + (size_t)(t + 2) * kstep; const char* b2 = last ? nB : cB + (size_t)(t + 2) * kstep;
            const char* a3 = a2 + kstep; const char* b3 = b2 + kstep;
            if (last && has_next) S.a_ready(nxt);
            if constexpr (SP2) {
            PG8_LDB(B0, 0, 0); PG8_LDB(B1, 0, 1); PG8_SCHED; PG8_LDA(At, 0, 0); PG8_STAGE(PG8_SA(1, 1), a1 + hstep, voffA);
            PG8_WAIT_V(8); PG8_WAIT_L(0); PG8_BAR; PG8_MMA(0, 0, At, B0); PG8_MMA(0, 1, At, B1); PG8_BAR; PG8_SCHED;
            PG8_LDA(At, 0, 1); PG8_STAGE(PG8_SB(0, 0), b2, voffB); PG8_STAGE(PG8_SB(0, 1), b2 + hstep, voffB); PG8_STAGE(PG8_SA(0, 0), a2, voffA);
            PG8_WAIT_V(8); PG8_WAIT_L(0); PG8_BAR; PG8_MMA(1, 0, At, B0); PG8_MMA(1, 1, At, B1); PG8_BAR; PG8_SCHED;
            PG8_LDB(B0, 1, 0); PG8_LDB(B1, 1, 1); PG8_SCHED; PG8_LDA(At, 1, 0); PG8_STAGE(PG8_SA(0, 1), a2 + hstep, voffA);
            PG8_WAIT_V(8); PG8_WAIT_L(0); PG8_BAR; PG8_MMA(0, 0, At, B0); PG8_MMA(0, 1, At, B1); PG8_BAR; PG8_SCHED;
            PG8_LDA(At, 1, 1); PG8_STAGE(PG8_SB(1, 0), b3, voffB); PG8_STAGE(PG8_SB(1, 1), b3 + hstep, voffB); PG8_STAGE(PG8_SA(1, 0), a3, voffA);
            PG8_WAIT_V(8); PG8_WAIT_L(0); PG8_BAR; PG8_MMA(1, 0, At, B0); PG8_MMA(1, 1, At, B1); PG8_BAR; PG8_SCHED;
            } else {
            PG8_LDB(B0, 0, 0); PG8_SCHED; PG8_LDA(At, 0, 0); PG8_STAGE(PG8_SA(1, 1), a1 + hstep, voffA);
            PG8_WAIT_L(8); PG8_BAR; PG8_WAIT_L(0); PG8_MMA(0, 0, At, B0); PG8_BAR; PG8_SCHED;
            PG8_LDB(B1, 0, 1); PG8_STAGE(PG8_SB(0, 0), b2, voffB);
            PG8_BAR; PG8_WAIT_L(0); PG8_MMA(0, 1, At, B1); PG8_BAR;
            PG8_LDA(At, 0, 1); PG8_STAGE(PG8_SA(0, 0), a2, voffA);
            PG8_BAR; PG8_WAIT_L(0); PG8_MMA(1, 0, At, B0); PG8_BAR; PG8_SCHED;
            PG8_STAGE(PG8_SB(0, 1), b2 + hstep, voffB);
            PG8_WAIT_V(6); PG8_BAR; PG8_MMA(1, 1, At, B1); PG8_BAR;
            PG8_LDB(B0, 1, 0); PG8_SCHED; PG8_LDA(At, 1, 0); PG8_STAGE(PG8_SA(0, 1), a2 + hstep, voffA);
            PG8_WAIT_L(8); PG8_BAR; PG8_WAIT_L(0); PG8_MMA(0, 0, At, B0); PG8_BAR; PG8_SCHED;
            PG8_LDB(B1, 1, 1); PG8_STAGE(PG8_SB(1, 0), b3, voffB);
            PG8_BAR; PG8_WAIT_L(0); PG8_MMA(0, 1, At, B1); PG8_BAR;
            PG8_LDA(At, 1, 1); PG8_STAGE(PG8_SA(1, 0), a3, voffA);
            PG8_BAR; PG8_WAIT_L(0); PG8_MMA(1, 0, At, B0); PG8_BAR; PG8_SCHED;
            PG8_STAGE(PG8_SB(1, 1), b3 + hstep, voffB);
            PG8_WAIT_V(6); PG8_BAR; PG8_MMA(1, 1, At, B1); PG8_BAR;
            }
        }
        if constexpr (ALIGN_EPI) { if (wr == 0) PG8_BAR; }
        if constexpr (!Epi::AFTER_DRAIN) { E(acc, cur, wr, wc, fr, fq); S.done(cur); }
        if (!has_next) break;
#pragma unroll
        for (int a = 0; a < 2; ++a)
#pragma unroll
            for (int b = 0; b < 2; ++b)
#pragma unroll
                for (int m = 0; m < 4; ++m)
#pragma unroll
                    for (int n = 0; n < 2; ++n) acc[a][b][m][n] = (f32x4){0.f, 0.f, 0.f, 0.f};
        cur = nxt; cA = nA; cB = nB; ++ui;
        if constexpr (ALIGN_EPI) { if (wr == 1) PG8_BAR; }
    }
    PG8_WAIT_V(0);
    if constexpr (!ALIGN_EPI) { if (wr == 0) PG8_BAR; }
    PG8_BAR;
    if constexpr (Epi::AFTER_DRAIN) { E.fused(acc, cur, wr, wc, fr, fq, lds, wid, lane); S.done(cur); }
#undef PG8_SA
#undef PG8_SB
#undef PG8_STAGE
#undef PG8_LDA
#undef PG8_LDB
#undef PG8_MMA
#undef PG8_WAIT_V
#undef PG8_WAIT_L
#undef PG8_BAR
#undef PG8_SCHED
}
}
namespace att {
#define LAS __attribute__((address_space(3)))
typedef unsigned short bf16_t;
typedef short bf16x8 __attribute__((ext_vector_type(8)));
typedef short s16x4 __attribute__((ext_vector_type(4)));
typedef short v4i16_t __attribute__((ext_vector_type(4)));
typedef float f32x4 __attribute__((ext_vector_type(4)));
typedef float f32x16 __attribute__((ext_vector_type(16)));
typedef unsigned u32x4 __attribute__((ext_vector_type(4)));
constexpr int KOFF = 0, VOFF = 16384, CUM_OFF = 32768, WSF_OFF = 49152, PF_OFF = 51200;
constexpr float LOG2E = 1.4426950408889634f;
__device__ __forceinline__ int crow(int r, int hi) { return (r & 3) + 8 * (r >> 2) + 4 * hi; }
__device__ __forceinline__ unsigned cvtpk(float lo, float hi) { unsigned r; asm volatile("v_cvt_pk_bf16_f32 %0, %1, %2" : "=v"(r) : "v"(lo), "v"(hi)); return r; }
__device__ __forceinline__ s16x4 vtr(const LAS unsigned char* p) { return __builtin_bit_cast(s16x4, __builtin_amdgcn_ds_read_tr16_b64_v4i16((LAS v4i16_t*)p)); }

struct Unit {
    const bf16_t* Q; const bf16_t* K; const bf16_t* V; bf16_t* O;
    long stride;
    int q0, t_lo, t_hi, window;
    int bias;
    int dry;
    float* lse; long lse_stride;
};

__device__ __forceinline__ void unit_run(LAS unsigned char* lds, const Unit& U) {
    int tid_ = threadIdx.x; asm volatile("" : "+v"(tid_)); const int tid = tid_, lane = tid & 63, r32 = lane & 31, hi = lane >> 5;
    const int wid = __builtin_amdgcn_readfirstlane(tid >> 6);
    const int srow = tid >> 3, sch = tid & 7;
    const bf16_t* kg = U.K + (long)srow * U.stride + sch * 8;
    const bf16_t* vg = U.V + (long)srow * U.stride + sch * 8;
    const int kst = KOFF + sch * 1024 + srow * 16;
    const int vst = VOFF + (sch >> 2) * 4096 + srow * 64 + (sch & 3) * 16;
    const int uq = U.q0 + wid * 32 + r32;
    bf16x8 qr[4];
#pragma unroll
    for (int d0 = 0; d0 < 4; ++d0) qr[d0] = *(const bf16x8*)(U.Q + (long)uq * U.stride + d0 * 16 + hi * 8);
    float m = -1e30f, l = 0.f;
    f32x16 o0, o1;
#pragma unroll
    for (int r = 0; r < 16; ++r) { o0[r] = 0.f; o1[r] = 0.f; }
    LAS float* wsf = (LAS float*)(lds + WSF_OFF) + wid * 64;
    const LAS float* cumL = (const LAS float*)(lds + CUM_OFF);
    const int wq_lo = U.q0 + wid * 32, wq_hi = wq_lo + 31;
    u32x4 kreg, vreg;
    {
        const long go = (long)U.t_lo * 64 * U.stride;
        kreg = *(const u32x4*)(kg + go); vreg = *(const u32x4*)(vg + go);
        *(LAS u32x4*)(lds + kst) = kreg; *(LAS u32x4*)(lds + vst) = vreg;
    }
    const LAS unsigned char* vp0 = lds + VOFF + ((lane >> 4) & 1) * 32 + (lane & 3) * 8 + (4 * hi + ((lane & 15) >> 2)) * 64;
    const LAS unsigned char* kp0 = lds + KOFF + hi * 1024 + r32 * 16;
    for (int t = U.t_lo; t < U.t_hi; ++t) {
        const int cur = (t - U.t_lo) & 1;
        const bool more = (t + 1 < U.t_hi);
        if (more) { const long go = (long)(t + 1) * 64 * U.stride; kreg = *(const u32x4*)(kg + go); vreg = *(const u32x4*)(vg + go); }
        __syncthreads();
        const bool need = (64 * t <= wq_hi) && (64 * t + 63 >= wq_lo - U.window);
        if (need) {
            const LAS unsigned char* kb = kp0 + cur * 8192;
            f32x16 p0, p1;
#pragma unroll
            for (int r = 0; r < 16; ++r) { p0[r] = 0.f; p1[r] = 0.f; }
#pragma unroll
            for (int d0 = 0; d0 < 4; ++d0) {
                const bf16x8 b0 = *(const LAS bf16x8*)(kb + d0 * 2048), b1 = *(const LAS bf16x8*)(kb + d0 * 2048 + 512);
                p0 = __builtin_amdgcn_mfma_f32_32x32x16_bf16(b0, qr[d0], p0, 0, 0, 0);
                p1 = __builtin_amdgcn_mfma_f32_32x32x16_bf16(b1, qr[d0], p1, 0, 0, 0);
            }
            if (U.bias) {
#pragma unroll
                for (int g = 0; g < 4; ++g) {
                    const f32x4 c0 = *(const LAS f32x4*)(cumL + 64 * t + 8 * g + 4 * hi), c1 = *(const LAS f32x4*)(cumL + 64 * t + 32 + 8 * g + 4 * hi);
#pragma unroll
                    for (int e = 0; e < 4; ++e) { p0[4 * g + e] += c0[e]; p1[4 * g + e] += c1[e]; }
                }
            }
            const bool need_mask = (64 * t + 63 > wq_lo) || (64 * t < wq_hi - U.window);
            if (need_mask) {
                const int lo_ok = uq - U.window;
#pragma unroll
                for (int r = 0; r < 16; ++r) {
                    const int kv = 64 * t + crow(r, hi);
                    if (kv > uq || kv < lo_ok) p0[r] = -INFINITY;
                    if (kv + 32 > uq || kv + 32 < lo_ok) p1[r] = -INFINITY;
                }
            }
            float mx = fmaxf(p0[0], p1[0]);
#pragma unroll
            for (int r = 1; r < 16; ++r) mx = fmaxf(mx, fmaxf(p0[r], p1[r]));
            mx = fmaxf(mx, __shfl_xor(mx, 32));
            const float mn = fmaxf(m, mx);
            const float alpha = __builtin_amdgcn_exp2f(m - mn);
            m = mn;
            float rs = 0.f;
#pragma unroll
            for (int r = 0; r < 16; ++r) { p0[r] = __builtin_amdgcn_exp2f(p0[r] - mn); p1[r] = __builtin_amdgcn_exp2f(p1[r] - mn); rs += p0[r] + p1[r]; }
            l = l * alpha + rs;
            if (hi == 0) wsf[r32] = alpha;
#pragma unroll
            for (int g = 0; g < 4; ++g) {
                const f32x4 a = *(const LAS f32x4*)(wsf + 8 * g + 4 * hi);
#pragma unroll
                for (int e = 0; e < 4; ++e) { o0[4 * g + e] *= a[e]; o1[4 * g + e] *= a[e]; }
            }
            u32x4 pw[4];
#pragma unroll
            for (int c = 0; c < 4; ++c) {
                pw[0][c] = cvtpk(p0[2 * c], p0[2 * c + 1]); pw[1][c] = cvtpk(p0[8 + 2 * c], p0[8 + 2 * c + 1]);
                pw[2][c] = cvtpk(p1[2 * c], p1[2 * c + 1]); pw[3][c] = cvtpk(p1[8 + 2 * c], p1[8 + 2 * c + 1]);
            }
            const LAS unsigned char* vp = vp0 + cur * 8192;
#pragma unroll
            for (int ks = 0; ks < 4; ++ks) {
                const s16x4 a0 = vtr(vp + ks * 1024), a1 = vtr(vp + ks * 1024 + 512), c0 = vtr(vp + 4096 + ks * 1024), c1 = vtr(vp + 4096 + ks * 1024 + 512);
                const bf16x8 pa = __builtin_bit_cast(bf16x8, pw[ks]);
                const bf16x8 v0 = (bf16x8){a0[0], a0[1], a0[2], a0[3], a1[0], a1[1], a1[2], a1[3]};
                const bf16x8 v1 = (bf16x8){c0[0], c0[1], c0[2], c0[3], c1[0], c1[1], c1[2], c1[3]};
                o0 = __builtin_amdgcn_mfma_f32_32x32x16_bf16(pa, v0, o0, 0, 0, 0);
                o1 = __builtin_amdgcn_mfma_f32_32x32x16_bf16(pa, v1, o1, 0, 0, 0);
            }
        }
        if (more) { *(LAS u32x4*)(lds + kst + (cur ^ 1) * 8192) = kreg; *(LAS u32x4*)(lds + vst + (cur ^ 1) * 8192) = vreg; }
    }
    l += __shfl_xor(l, 32);
    if (hi == 0) { wsf[32 + r32] = l; if (U.lse && !U.dry) U.lse[(long)uq * U.lse_stride] = m + __builtin_amdgcn_logf(l); }
    if (U.dry) return;
    bf16_t* Ow = U.O + (long)(U.q0 + wid * 32) * U.stride;
#pragma unroll
    for (int g = 0; g < 4; ++g) {
        const f32x4 lv = *(const LAS f32x4*)(wsf + 32 + 8 * g + 4 * hi);
#pragma unroll
        for (int e = 0; e < 4; ++e) {
            const int r = 4 * g + e; const float rl = 1.0f / lv[e];
            bf16_t* op = Ow + (long)crow(r, hi) * U.stride + r32;
            const unsigned w0 = cvtpk(o0[r] * rl, 0.f), w1 = cvtpk(o1[r] * rl, 0.f);
            op[0] = (bf16_t)(w0 & 0xffffu); op[32] = (bf16_t)(w1 & 0xffffu);
        }
    }
}
#undef LAS
}
namespace fatt {
using bf16=__hip_bfloat16;
using bf16x8=__attribute__((ext_vector_type(8)))short;
using s16x4=__attribute__((ext_vector_type(4)))short;
using f32x16=__attribute__((ext_vector_type(16)))float;
using u32x4=__attribute__((ext_vector_type(4)))unsigned;
constexpr int BATCH=8,NHEAD=16,SEQ=4096,D=64,DM=NHEAD*D;
constexpr int NW=8,QBLK=32,QB=QBLK*NW,KVBLK=64,NQB=SEQ/QB;
constexpr int ATTN_PITCH=DM, ATTN_UNIT_ROWS=QB;
__device__ __forceinline__ int crow(int r,int hi){return (r&3)+8*(r>>2)+4*hi;}
#define SBAR() __builtin_amdgcn_sched_barrier(0)
__device__ __forceinline__ void cmask(f32x16&p0,f32x16&p1,int jb,int qrel,int hi){
  const float NEG=-INFINITY; int kb=64*jb+4*hi;
  #pragma unroll
  for(int r=0;r<16;++r){int kv=kb+(r&3)+8*(r>>2); if(kv>qrel)p0[r]=NEG; if(kv+32>qrel)p1[r]=NEG;}
}

constexpr int NSLOT=3, SLOTB=8192;
constexpr int LDS_K=0, LDS_V=NSLOT*SLOTB, LDS_WS=2*NSLOT*SLOTB, LDS_OST=LDS_WS+NW*64*4, LDS_BYTES=LDS_OST+NW*4096;
constexpr int D_OFF=LDS_BYTES, CT_OFF=D_OFF+16384+256, PFX_OFF=CT_OFF+512, WT_OFF=PFX_OFF+1024, FOX_LDS_BYTES=WT_OFF+64;
constexpr float C2=0.125f*1.4426950408889634f;
__device__ __forceinline__ void glds16(const void*gsrc,unsigned lds_dst){unsigned keep;
  asm volatile("s_mov_b32 %0, m0\n\ts_mov_b32 m0, %2\n\ts_nop 0\n\tglobal_load_lds_dwordx4 %1, off\n\ts_mov_b32 m0, %0":"=&s"(keep):"v"(gsrc),"s"(lds_dst):"memory");}
__device__ __forceinline__ float max3f(float a,float b,float c){float r;asm("v_max3_f32 %0, %1, %2, %3":"=v"(r):"v"(a),"v"(b),"v"(c));return r;}
__device__ __forceinline__ float max2f(float a,float b){float r;asm("v_max_f32_e32 %0, %1, %2":"=v"(r):"v"(a),"v"(b));return r;}
__device__ __forceinline__ float fadd_s(float a,float b){float r;asm("v_add_f32_e32 %0, %1, %2":"=v"(r):"v"(a),"v"(b));return r;}
__device__ __forceinline__ float fsub_s(float a,float b){float r;asm("v_sub_f32_e32 %0, %1, %2":"=v"(r):"v"(a),"v"(b));return r;}
typedef float f32x2_t __attribute__((ext_vector_type(2))); typedef __bf16 bf16x2_t __attribute__((ext_vector_type(2)));
__device__ __forceinline__ unsigned cvtpk_s(float lo,float hi){f32x2_t v={lo,hi};bf16x2_t b=__builtin_convertvector(v,bf16x2_t);return __builtin_bit_cast(unsigned,b);}
#define WAIT_BAR(N) asm volatile("s_waitcnt vmcnt(" #N ") lgkmcnt(0)\n\ts_barrier":::"memory")

__device__ __forceinline__ void qkt(f32x16&p0,f32x16&p1,const char*Kslot,const bf16x8*qr,const f32x16&negm,int r32,int hi){
  const char*kb=Kslot+hi*1024+r32*16;
  #pragma unroll
  for(int d0=0;d0<4;++d0){
    const bf16x8 b0=*reinterpret_cast<const bf16x8*>(kb+d0*2048);
    const bf16x8 b1=*reinterpret_cast<const bf16x8*>(kb+d0*2048+512);
    if(d0==0){p0=__builtin_amdgcn_mfma_f32_32x32x16_bf16(b0,qr[0],negm,0,0,0);p1=__builtin_amdgcn_mfma_f32_32x32x16_bf16(b1,qr[0],negm,0,0,0);}
    else{p0=__builtin_amdgcn_mfma_f32_32x32x16_bf16(b0,qr[d0],p0,0,0,0);p1=__builtin_amdgcn_mfma_f32_32x32x16_bf16(b1,qr[d0],p1,0,0,0);}}
}
typedef __attribute__((address_space(3))) const char* lds_cptr;
typedef short v4i16_t __attribute__((ext_vector_type(4)));
typedef float f32x4v __attribute__((ext_vector_type(4)));
__device__ __forceinline__ void kload8(bf16x8*kf,lds_cptr kp){
  kf[0]=*(const __attribute__((address_space(3))) bf16x8*)(kp);      kf[1]=*(const __attribute__((address_space(3))) bf16x8*)(kp+512);
  kf[2]=*(const __attribute__((address_space(3))) bf16x8*)(kp+2048); kf[3]=*(const __attribute__((address_space(3))) bf16x8*)(kp+2560);
  kf[4]=*(const __attribute__((address_space(3))) bf16x8*)(kp+4096); kf[5]=*(const __attribute__((address_space(3))) bf16x8*)(kp+4608);
  kf[6]=*(const __attribute__((address_space(3))) bf16x8*)(kp+6144); kf[7]=*(const __attribute__((address_space(3))) bf16x8*)(kp+6656);
}
__device__ __forceinline__ void kload2(bf16x8*kf,lds_cptr kp,int j){ kf[2*j]=*(const __attribute__((address_space(3))) bf16x8*)(kp+j*2048); kf[2*j+1]=*(const __attribute__((address_space(3))) bf16x8*)(kp+j*2048+512); }
__device__ __forceinline__ s16x4 vtr(lds_cptr p){ return __builtin_bit_cast(s16x4,__builtin_amdgcn_ds_read_tr16_b64_v4i16((__attribute__((address_space(3))) v4i16_t*)p)); }
__device__ __forceinline__ float rowmax(const f32x16&p0,const f32x16&p1){
  float a=max3f(p0[0],p0[1],p1[0]),b=max3f(p0[2],p0[3],p1[1]);a=max3f(a,p1[2],p1[3]);
  #pragma unroll
  for(int r=4;r<16;r+=4){a=max3f(a,p0[r],p0[r+1]);b=max3f(b,p0[r+2],p0[r+3]);a=max3f(a,p1[r],p1[r+1]);b=max3f(b,p1[r+2],p1[r+3]);}
  const float m=max2f(a,b);
  auto rr=__builtin_amdgcn_permlane32_swap(__float_as_uint(m),__float_as_uint(m),false,false);
  return max2f(__uint_as_float(rr[0]),__uint_as_float(rr[1]));
}
__device__ __forceinline__ void pv(f32x16*o,int vb,bf16x8 pa0,bf16x8 pa1,bf16x8 pa2,bf16x8 pa3){
  #pragma unroll
  for(int d0=0;d0<2;++d0){s16x4 lo[4],hi[4];
    #pragma unroll
    for(int ks=0;ks<4;++ks){
      asm volatile("ds_read_b64_tr_b16 %0,%1 offset:%c2":"=&v"(lo[ks]):"v"(vb),"i"(d0*4096+ks*1024):"memory");
      asm volatile("ds_read_b64_tr_b16 %0,%1 offset:%c2":"=&v"(hi[ks]):"v"(vb),"i"(d0*4096+ks*1024+512):"memory");}
    asm volatile("s_waitcnt lgkmcnt(0)":::"memory");SBAR();
    #define PK(k) (bf16x8){lo[k][0],lo[k][1],lo[k][2],lo[k][3],hi[k][0],hi[k][1],hi[k][2],hi[k][3]}
    o[d0]=__builtin_amdgcn_mfma_f32_32x32x16_bf16(pa0,PK(0),o[d0],0,0,0);
    o[d0]=__builtin_amdgcn_mfma_f32_32x32x16_bf16(pa1,PK(1),o[d0],0,0,0);
    o[d0]=__builtin_amdgcn_mfma_f32_32x32x16_bf16(pa2,PK(2),o[d0],0,0,0);
    o[d0]=__builtin_amdgcn_mfma_f32_32x32x16_bf16(pa3,PK(3),o[d0],0,0,0);
    #undef PK
  }
}

#ifndef ATTN_STORE16
#define ATTN_STORE16(p,v) (*(u32x4*)(p)=(v))
#endif
template<int THRL> __device__ __forceinline__ void attn_unit(int b,int h,int qb,const bf16*Q,const bf16*__restrict__ K,const bf16*__restrict__ V,bf16*O,char*shm){
  int tid_=threadIdx.x; asm volatile("":"+v"(tid_)); const int tid=tid_,lane=tid&63,r32=lane&31,hi=lane>>5; const int wid=__builtin_amdgcn_readfirstlane(tid>>6);
  const long rowbase=(long)b*SEQ; const int q0=qb*QB;
  const bf16*Qw=Q+(rowbase+q0+wid*QBLK)*DM+h*D;
  const bf16*Kh=K+rowbase*DM+h*D,*Vh=V+rowbase*DM+h*D;
  const unsigned lds0=(unsigned)(uintptr_t)shm;
  float*wsf=(float*)(shm+LDS_WS)+wid*64;
  const bf16*ksrc=Kh+(long)lane*DM+wid*8;
  const bf16*vsrc=Vh+(long)(16*(wid&3)+(lane>>2))*DM+(wid>>2)*32+(lane&3)*8;
  const unsigned kdst=lds0+LDS_K+wid*1024, vdst=lds0+LDS_V+wid*1024;
  #define DMA_K(t,slot) glds16(ksrc+(long)(t)*KVBLK*DM,(unsigned)__builtin_amdgcn_readfirstlane(kdst+(slot)))
  #define DMA_V(t,slot) glds16(vsrc+(long)(t)*KVBLK*DM,(unsigned)__builtin_amdgcn_readfirstlane(vdst+(slot)))
  const int vb0=(int)(lds0+LDS_V)+((lane>>4)&1)*32+(lane&3)*8+(4*hi+((lane&15)>>2))*64;
  const char*Kbase=shm+LDS_K; bf16x8 kf[8];
  typedef __attribute__((address_space(3))) const float* lds_fptr; typedef __attribute__((address_space(3))) const f32x4v* lds_f4ptr;
  const lds_cptr shm3=(lds_cptr)shm; const lds_fptr dLh=(lds_fptr)(shm3+D_OFF)+4*hi; const lds_fptr ctL=(lds_fptr)(shm3+CT_OFF); const lds_cptr kp0=shm3+LDS_K+hi*1024+r32*16; const lds_cptr vp0=shm3+LDS_V+((lane>>4)&1)*32+(lane&3)*8+(4*hi+((lane&15)>>2))*64;
  const int NT=(q0+QB)/KVBLK;
  DMA_K(0,0);DMA_V(0,0);DMA_K(1,SLOTB);
  bf16x8 qr[4];
  #pragma unroll
  for(int d0=0;d0<4;++d0)qr[d0]=*reinterpret_cast<const bf16x8*>(&Qw[(long)r32*DM+d0*16+hi*8]);
  float mhat=0.f,l_reg=0.f;f32x16 o[2];o[0]=f32x16{};o[1]=f32x16{};float cmv=ctL[0]; float ctn=ctL[1];
  #define DLD(t,j) (*(lds_f4ptr)(dLh+64*(t)+8*(j)))
  const int qrel=wid*QBLK+r32;
  #define CMASK(P0,P1,t) do{int jb_=(t)-(NT-4); if(jb_>=0)cmask(P0,P1,jb_,qrel,hi);}while(0)
  bool resc=false;
  #define START(P0,P1) do{ const float rm=fadd_s(rowmax(P0,P1),cmv); resc=false; mhat=fadd_s(mhat,rm); cmv=fsub_s(cmv,rm); \
    _Pragma("unroll") for(int j_=0;j_<4;++j_){ const f32x4v dv_=DLD(0,j_); _Pragma("unroll") for(int e_=0;e_<4;++e_)P0[4*j_+e_]=__builtin_amdgcn_exp2f(P0[4*j_+e_]+(dv_[e_]+cmv)); } }while(0)
  #define RESC() do{ if(resc){ asm volatile("s_waitcnt lgkmcnt(0)":::"memory"); \
      _Pragma("unroll") for(int d_=0;d_<2;++d_) _Pragma("unroll") for(int r=0;r<16;++r)o[d_][r]*=wsf[crow(r,hi)]; } }while(0)
  f32x16 pA0,pA1,pB0,pB1;
  int sl_prev=0,sl_cur=0,sl_next=SLOTB;
  #define ROT() do{sl_prev=sl_cur;sl_cur=sl_next;sl_next=(sl_next==(NSLOT-1)*SLOTB)?0:sl_next+SLOTB;}while(0)
  DMA_K(2,2*SLOTB);
  WAIT_BAR(3);
  qkt(pA0,pA1,Kbase,qr,f32x16{},r32,hi);asm volatile("s_nop 15\n\ts_nop 7":"+v"(pA0),"+v"(pA1));CMASK(pA0,pA1,0);
  START(pA0,pA1);
  _Pragma("unroll") for(int j_=0;j_<4;++j_){ const f32x4v dv_=DLD(0,4+j_); _Pragma("unroll") for(int e_=0;e_<4;++e_)pA1[4*j_+e_]=__builtin_amdgcn_exp2f(pA1[4*j_+e_]+(dv_[e_]+cmv)); }
  WAIT_BAR(0);
  DMA_K(3,0);DMA_V(1,SLOTB);
  ROT();
  kload8(kf,kp0+sl_cur);
  WAIT_BAR(2);
  s16x4 vlo[8],vhi[8]; u32x4 pw0,pw1,pw2,pw3;
  #define PKW(P,B) cvtpk_s(P[B],P[B+1])
  #define PAF(k) __builtin_bit_cast(bf16x8,pw##k)
  #define VFR(i) (bf16x8){vlo[i][0],vlo[i][1],vlo[i][2],vlo[i][3],vhi[i][0],vhi[i][1],vhi[i][2],vhi[i][3]}
  #define PIN(x) asm volatile("":"+v"(x))
  #define MX3(a,b,c) __builtin_fmaxf(__builtin_fmaxf((a),(b)),(c))
  #define GAPA(MF,A0,A1,A2,A3,W0,W1,PW) do{ MF; sacc+=A0; sacc+=A1; sacc+=A2; sacc+=A3; PIN(sacc); W0; W1; PIN(PW); SBAR(); }while(0)
  #define EX(v) __builtin_amdgcn_exp2f(v)
  #define GAPB(MF,X,B,DC,DN,JN) do{ MF; dA_=dA_+cmv; X[B]=EX(X[B]+dA_[0]); X[B+1]=EX(X[B+1]+dA_[1]); X[B+2]=EX(X[B+2]+dA_[2]); X[B+3]=EX(X[B+3]+dA_[3]); dA_=dp_[2*(JN)]; PIN(X); SBAR(); }while(0)
  #define VRD(i) do{ vlo[i]=vtr(vp_+(((i)>>2)*4096+((i)&3)*1024)); vhi[i]=vtr(vp_+(((i)>>2)*4096+((i)&3)*1024+512)); }while(0)
  #define KRD(G,j) do{ if(G){ kload2(kf,kp0+sl_next,j); SBAR(); } }while(0)
  #define STEP(C0,C1,P0,P1,t,GK,GV,GL) do{ SBAR(); \
    cmv=fsub_s(ctn,mhat); ctn=ctL[(t)+1]; \
    const lds_f4ptr dp_=(lds_f4ptr)(dLh+64*(t)); f32x4v dA_; \
    const lds_cptr vp_=vp0+sl_prev; \
    VRD(0); SBAR(); float sacc=(P0[0]+P0[1]); \
    GAPA(C0=__builtin_amdgcn_mfma_f32_32x32x16_bf16(kf[0],qr[0],f32x16{},0,0,0), P0[2],P0[3],P0[4],P0[5],     pw0[0]=PKW(P0,0), pw0[1]=PKW(P0,2), pw0); \
    VRD(4); SBAR(); GAPA(C1=__builtin_amdgcn_mfma_f32_32x32x16_bf16(kf[1],qr[0],f32x16{},0,0,0), P0[6],P0[7],P0[8],P0[9],     pw0[2]=PKW(P0,4), pw0[3]=PKW(P0,6), pw0); \
    VRD(1); SBAR(); GAPA(C0=__builtin_amdgcn_mfma_f32_32x32x16_bf16(kf[2],qr[1],C0,0,0,0),   P0[10],P0[11],P0[12],P0[13], pw1[0]=PKW(P0,8), pw1[1]=PKW(P0,10), pw1); \
    VRD(5); SBAR(); GAPA(C1=__builtin_amdgcn_mfma_f32_32x32x16_bf16(kf[3],qr[1],C1,0,0,0),   P0[14],P0[15],P1[0],P1[1],   pw1[2]=PKW(P0,12),pw1[3]=PKW(P0,14), pw1); \
    VRD(2); SBAR(); GAPA(C0=__builtin_amdgcn_mfma_f32_32x32x16_bf16(kf[4],qr[2],C0,0,0,0),   P1[2],P1[3],P1[4],P1[5],     pw2[0]=PKW(P1,0), pw2[1]=PKW(P1,2), pw2); \
    VRD(6); SBAR(); GAPA(C1=__builtin_amdgcn_mfma_f32_32x32x16_bf16(kf[5],qr[2],C1,0,0,0),   P1[6],P1[7],P1[8],P1[9],     pw2[2]=PKW(P1,4), pw2[3]=PKW(P1,6), pw2); \
    VRD(3); SBAR(); GAPA(C0=__builtin_amdgcn_mfma_f32_32x32x16_bf16(kf[6],qr[3],C0,0,0,0),   P1[10],P1[11],P1[12],P1[13], pw3[0]=PKW(P1,8), pw3[1]=PKW(P1,10), pw3); \
    VRD(7); SBAR(); GAPA(C1=__builtin_amdgcn_mfma_f32_32x32x16_bf16(kf[7],qr[3],C1,0,0,0),   P1[14],P1[15],0.f,0.f,       pw3[2]=PKW(P1,12),pw3[3]=PKW(P1,14), pw3); \
    l_reg+=sacc; \
    if(GK){DMA_K((t)+3,sl_cur);} if(GV){DMA_V((t)+1,sl_next);} dA_=dp_[0]; \
    CMASK(C0,C1,t); \
    { float a=MX3(C0[0],C0[1],C1[0]),b=MX3(C0[2],C0[3],C1[1]); a=MX3(a,C1[2],C1[3]); \
      _Pragma("unroll") for(int r=4;r<16;r+=4){a=MX3(a,C0[r],C0[r+1]);b=MX3(b,C0[r+2],C0[r+3]);a=MX3(a,C1[r],C1[r+1]);b=MX3(b,C1[r+2],C1[r+3]);} \
      float rm=__builtin_fmaxf(a,b); { auto rr=__builtin_amdgcn_permlane32_swap(__float_as_uint(rm),__float_as_uint(rm),false,false); rm=__builtin_fmaxf(__uint_as_float(rr[0]),__uint_as_float(rr[1])); } \
      rm+=cmv; resc=false; \
      if(__builtin_expect(__any(rm>(float)THRL),0)){ const float dl=__builtin_fmaxf(rm,0.f); mhat+=dl; cmv-=dl; \
        const float f=__builtin_amdgcn_exp2f(-dl); l_reg*=f; if(hi==0)wsf[r32]=f; resc=true; } } \
    SBAR(); \
    GAPB(o[0]=__builtin_amdgcn_mfma_f32_32x32x16_bf16(PAF(0),VFR(0),o[0],0,0,0), C0,0,dA_,dB_,1); \
    GAPB(o[1]=__builtin_amdgcn_mfma_f32_32x32x16_bf16(PAF(0),VFR(4),o[1],0,0,0), C0,4,dB_,dA_,2); \
    KRD(GL,0); GAPB(o[0]=__builtin_amdgcn_mfma_f32_32x32x16_bf16(PAF(1),VFR(1),o[0],0,0,0), C0,8,dA_,dB_,3); \
    KRD(GL,1); GAPB(o[1]=__builtin_amdgcn_mfma_f32_32x32x16_bf16(PAF(1),VFR(5),o[1],0,0,0), C0,12,dB_,dA_,4); \
    KRD(GL,2); GAPB(o[0]=__builtin_amdgcn_mfma_f32_32x32x16_bf16(PAF(2),VFR(2),o[0],0,0,0), C1,0,dA_,dB_,5); \
    KRD(GL,3); GAPB(o[1]=__builtin_amdgcn_mfma_f32_32x32x16_bf16(PAF(2),VFR(6),o[1],0,0,0), C1,4,dB_,dA_,6); \
    GAPB(o[0]=__builtin_amdgcn_mfma_f32_32x32x16_bf16(PAF(3),VFR(3),o[0],0,0,0), C1,8,dA_,dB_,7); \
    GAPB(o[1]=__builtin_amdgcn_mfma_f32_32x32x16_bf16(PAF(3),VFR(7),o[1],0,0,0), C1,12,dB_,dA_,7); \
    }while(0)
  int t=1;
  #undef CMASK
  #define CMASK(P0,P1,t) do{}while(0)
  for(;t+5<NT;t+=2){
    STEP(pB0,pB1,pA0,pA1,t,true,true,true);     WAIT_BAR(2); RESC(); ROT();
    STEP(pA0,pA1,pB0,pB1,t+1,true,true,true);   WAIT_BAR(2); RESC(); ROT();
  }
  #undef CMASK
  #define CMASK(P0,P1,t) do{int jb_=(t)-(NT-4); if(jb_>=0)cmask(P0,P1,jb_,qrel,hi);}while(0)
  #define ENDW(tt) do{ if((tt)+3<NT){WAIT_BAR(2);} else if((tt)+2<NT){WAIT_BAR(1);} else {WAIT_BAR(0);} }while(0)
  for(;t+1<NT;t+=2){
    STEP(pB0,pB1,pA0,pA1,t,(t+3<NT),(t+1<NT),(t+1<NT));       ENDW(t);   RESC(); ROT();
    STEP(pA0,pA1,pB0,pB1,t+1,(t+4<NT),(t+2<NT),(t+2<NT));     ENDW(t+1); RESC(); ROT();
  }
  STEP(pB0,pB1,pA0,pA1,NT-1,false,false,false); RESC();
  { float sacc=pB0[0]+pB0[1]; _Pragma("unroll") for(int r=2;r<16;++r)sacc+=pB0[r]; _Pragma("unroll") for(int r=0;r<16;++r)sacc+=pB1[r]; l_reg+=sacc;
    pw0=(u32x4){PKW(pB0,0),PKW(pB0,2),PKW(pB0,4),PKW(pB0,6)};pw1=(u32x4){PKW(pB0,8),PKW(pB0,10),PKW(pB0,12),PKW(pB0,14)};pw2=(u32x4){PKW(pB1,0),PKW(pB1,2),PKW(pB1,4),PKW(pB1,6)};pw3=(u32x4){PKW(pB1,8),PKW(pB1,10),PKW(pB1,12),PKW(pB1,14)};
    SBAR(); pv(o,vb0+sl_cur,PAF(0),PAF(1),PAF(2),PAF(3)); }
  #undef PKW
  #undef PAF
  #undef VFR
  #undef PIN
  #undef MX3
  #undef GAPA
  #undef GAPB
  #undef EX
  #undef VRD
  #undef KRD
  #undef STEP
  #undef ENDW
  {auto rr=__builtin_amdgcn_permlane32_swap(__float_as_uint(l_reg),__float_as_uint(l_reg),false,false);l_reg=__uint_as_float(rr[0])+__uint_as_float(rr[1]);}
  if(hi==0)wsf[32+r32]=l_reg;asm volatile("s_waitcnt lgkmcnt(0)":::"memory");
  float rli[16];
  #pragma unroll
  for(int r=0;r<16;++r)rli[r]=__builtin_amdgcn_rcpf(wsf[32+crow(r,hi)]);
  bf16*Ow=O+(rowbase+q0+wid*QBLK)*DM+h*D;
  { bf16*stg=(bf16*)(shm+LDS_OST)+wid*2048;
    #pragma unroll
    for(int r=0;r<16;++r){const int orow=crow(r,hi);
      #pragma unroll
      for(int d0=0;d0<2;++d0)stg[orow*64+d0*32+r32]=__float2bfloat16(o[d0][r]*rli[r]);}
    asm volatile("s_waitcnt lgkmcnt(0)":::"memory");
    #pragma unroll
    for(int i=0;i<4;++i){const int row=i*8+(lane>>3),ch=lane&7; const u32x4 v=*(const u32x4*)(stg+row*64+ch*8); ATTN_STORE16(Ow+(long)row*DM+ch*8,v);} }
  asm volatile("s_waitcnt lgkmcnt(0)\n\ts_barrier":::"memory");
  #undef DMA_K
  #undef DLD
  #undef DMA_V
  #undef CMASK
  #undef START
  #undef RESC
  #undef ROT
}
constexpr int ATTN_LDS_BYTES=LDS_BYTES;
struct AttnTensors { const bf16* Q; const bf16* K; const bf16* V; bf16* O; };
struct AttnUnit { int bh; int qb; };
struct StaticOrder {
  int vcu;
  __device__ __forceinline__ explicit StaticOrder(int grid,int block):vcu((block%8)*(grid/8)+block/8){}
  __device__ __forceinline__ bool next(int i,AttnUnit&u)const{ if(i>=4)return false; const int s=vcu&7; u.bh=vcu>>3; u.qb=(i==0)?s:(i==1)?15-s:(i==2)?16+s:31-s; return true; }
  __device__ __forceinline__ void a_ready(const AttnUnit&)const{}
  __device__ __forceinline__ void done(const AttnUnit&)const{}
};
template<class Sched,int THRL=8> __device__ __forceinline__ void attn_phase(char*lds,const AttnTensors&T,const Sched&S){
  AttnUnit u;
  for(int i=0;S.next(i,u);++i){ S.a_ready(u); attn_unit<THRL>(u.bh/NHEAD,u.bh%NHEAD,u.qb,T.Q,T.K,T.V,T.O,lds); S.done(u); }
}
#undef SBAR
#undef WAIT_BAR
}
#define LAS __attribute__((address_space(3)))
typedef unsigned short bf16_t;
typedef float f32x4 __attribute__((ext_vector_type(4)));
typedef unsigned u32x4 __attribute__((ext_vector_type(4)));
typedef unsigned u32x2 __attribute__((ext_vector_type(2)));

constexpr int NB = 8, SEQ = 4096, DM = 1024, MT = NB * SEQ, FF = 2816, NH = 16, MODN = 9216;
constexpr int NTHREADS = 512, NWAVES = 8;
constexpr float LOG2E = 1.4426950408889634f;
constexpr size_t MiB = (size_t)1 << 20;
constexpr size_t WS_BAR = 0, WS_BAR_BYTES = 16384;
constexpr size_t WS_MOD = 1 * MiB, WS_COS = 3 * MiB, WS_SIN = 4 * MiB, WS_CUM = 5 * MiB, WS_CHT = 7 * MiB, WS_LSE = 8 * MiB;
constexpr size_t WS_W = 16 * MiB, FFN_BLK = (size_t)(2 * FF * DM + DM * FF) * 2, FFN_DOWN_OFF = (size_t)2 * FF * DM * 2;
constexpr size_t WS_FOXIN = WS_W + 8 * FFN_BLK, FOXIN_SZ = (size_t)3072 * DM * 2;
constexpr size_t WS_FOXOUT = WS_FOXIN + 2 * FOXIN_SZ, OUT_SZ = (size_t)DM * DM * 2;
constexpr size_t WS_DILIN = WS_FOXOUT + 2 * OUT_SZ, DILIN_SZ = (size_t)9216 * DM * 2;
constexpr size_t WS_DILOUT = WS_DILIN + 2 * DILIN_SZ;
constexpr size_t WS_H = WS_DILOUT + 2 * OUT_SZ;
constexpr size_t WS_BIG = WS_H + (size_t)MT * DM * 2;
constexpr size_t WS_END = WS_BIG + (size_t)(MT / 2) * 9216 * 2;
static_assert(WS_W + 8 * FFN_BLK == 148 * MiB && WS_H == 204 * MiB && WS_END == 556 * MiB, "workspace map");
constexpr int LDS_BYTES = 147456;

__device__ __forceinline__ unsigned f2bf(float f) { unsigned u = __builtin_bit_cast(unsigned, f); return (u + 0x7fffu + ((u >> 16) & 1u)) >> 16; }
__device__ __forceinline__ unsigned pk2(float lo, float hi) { return f2bf(lo) | (f2bf(hi) << 16); }
__device__ __forceinline__ float bflo(unsigned w) { return __builtin_bit_cast(float, w << 16); }
__device__ __forceinline__ float bfhi(unsigned w) { return __builtin_bit_cast(float, w & 0xffff0000u); }
__device__ __forceinline__ float wave_sum(float v) {
#pragma unroll
    for (int o = 1; o < 64; o <<= 1) v += __shfl_xor(v, o);
    return v;
}

__device__ __forceinline__ int fresh_tid() { int t = threadIdx.x; asm volatile("" : "+v"(t)); return t; }
struct Args { const void* in[18]; float* out; unsigned char* ws; int ph_lo, ph_hi; };

__device__ __forceinline__ int map_row(int kind, int n0) {
    if (kind == 0) return n0;
    if (kind == 1) return 256 * (n0 >> 7) + (n0 & 127);
    if (kind == 2) return 256 * (n0 >> 7) + 128 + (n0 & 127);
    return (n0 & ~255) + 128 * ((n0 >> 5) & 1) + 32 * ((n0 >> 6) & 3);
}
__device__ __forceinline__ void conv_item(const float* W, int K, int Npitch, int nblk, bf16_t* WT, int kind, LAS float* scr, int item, int lane) {
    const int kb = item / nblk, nb = item % nblk, k0 = 64 * kb, n0 = 32 * nb;
    const int drow0 = map_row(kind, n0);
#pragma unroll 8
    for (int i = 0; i < 32; ++i) { const int kk = 2 * i + (lane >> 5); scr[kk * 33 + (lane & 31)] = W[(size_t)(k0 + kk) * Npitch + n0 + (lane & 31)]; }
    asm volatile("s_waitcnt lgkmcnt(0)" ::: "memory");
    const int c = lane & 7;
#pragma unroll
    for (int j = 0; j < 4; ++j) { const int n = (lane >> 3) + 8 * j; const LAS float* s = scr + (8 * c) * 33 + n;
        u32x4 o; o.x = pk2(s[0 * 33], s[1 * 33]); o.y = pk2(s[2 * 33], s[3 * 33]); o.z = pk2(s[4 * 33], s[5 * 33]); o.w = pk2(s[6 * 33], s[7 * 33]);
        *(u32x4*)(WT + (size_t)(drow0 + n) * K + k0 + 8 * c) = o; }
    asm volatile("s_waitcnt lgkmcnt(0)" ::: "memory");
}

template <class AT> __device__ __forceinline__ void prologue_phase(AT& a, LAS unsigned char* lds) {
    const int tid = fresh_tid(), lane = tid & 63, wid = __builtin_amdgcn_readfirstlane(tid >> 6);
    const int G = gridDim.x, bid = blockIdx.x;
    unsigned char* ws = a.ws;
    {
        const float* c = (const float*)a.in[1]; const float* mod_w = (const float*)a.in[3]; const float* mod_b = (const float*)a.in[4];
        float* modbuf = (float*)(ws + WS_MOD);
        LAS float* cact = (LAS float*)lds;
        LAS float* red = (LAS float*)(lds + 32768);
        for (int e = tid; e < NB * DM; e += NTHREADS) { const int b = e >> 10, k = e & 1023; const float v = c[e]; cact[k * 8 + b] = v / (1.0f + __expf(-v)); }
        __syncthreads();
        for (int task = bid; task < 4 * 144; task += G) {
            const int i = task / 144, n0 = (task % 144) * 64, n = n0 + lane;
            float acc[8];
#pragma unroll
            for (int b = 0; b < 8; ++b) acc[b] = 0.f;
            const float* wp = mod_w + ((size_t)i * DM + 128 * wid) * MODN + n;
#pragma unroll 4
            for (int kk = 0; kk < 128; ++kk) {
                const float wv = wp[(size_t)kk * MODN];
                const f32x4 c0 = *(const LAS f32x4*)(cact + (128 * wid + kk) * 8), c1 = *(const LAS f32x4*)(cact + (128 * wid + kk) * 8 + 4);
                acc[0] += c0[0] * wv; acc[1] += c0[1] * wv; acc[2] += c0[2] * wv; acc[3] += c0[3] * wv;
                acc[4] += c1[0] * wv; acc[5] += c1[1] * wv; acc[6] += c1[2] * wv; acc[7] += c1[3] * wv;
            }
#pragma unroll
            for (int b = 0; b < 8; ++b) red[(wid * 8 + b) * 64 + lane] = acc[b];
            __syncthreads();
            {
                const int b = tid >> 6; float s = 0.f;
#pragma unroll
                for (int w = 0; w < 8; ++w) s += red[(w * 8 + b) * 64 + lane];
                s += mod_b[(size_t)i * MODN + n];
                const int sidx = n / 3072, j = (n >> 10) % 3;
                if (j == 1) s += 1.0f;
                if (j == 2 && sidx != 1) s *= 0.5f;
                modbuf[((size_t)i * NB + b) * MODN + n] = s;
            }
            __syncthreads();
        }
    }
    __syncthreads();
    {
        const int* pos = (const int*)a.in[2];
        float* cs = (float*)(ws + WS_COS); float* sn = (float*)(ws + WS_SIN);
        for (int e = bid * NTHREADS + tid; e < MT * 8; e += G * NTHREADS) {
            const int i = e & 7;
            const float invf = (i == 0) ? 1.0f : (i == 1) ? 0.1939227432012558f : (i == 2) ? 0.03760603070259094f : (i == 3) ? 0.007292664609849453f
                             : (i == 4) ? 0.0014142135623842478f : (i == 5) ? 0.00027424818836152554f : (i == 6) ? 5.3182957344688475e-05f : 1.0313385246263351e-05f;
            const float ang = (float)pos[e >> 3] * invf;
            const double rev = (double)ang * 0.15915494309189535;
            const float fr = (float)(rev - floor(rev));
            cs[e] = __builtin_amdgcn_cosf(fr); sn[e] = __builtin_amdgcn_sinf(fr);
        }
    }
    {
        LAS float* scr = (LAS float*)(lds + wid * 16384);
        const float* wg = (const float*)a.in[6]; const float* wu = (const float*)a.in[7]; const float* wd = (const float*)a.in[8];
        const float* fin = (const float*)a.in[9]; const float* fout = (const float*)a.in[13];
        const float* din = (const float*)a.in[14]; const float* dout = (const float*)a.in[17];
        const int gw = bid * NWAVES + wid, NGW = G * NWAVES;
        constexpr int I_FFN = 1408, I_FIN = 1536, I_OUT = 512, I_DIN = 4608;
        constexpr int NITEMS = 8 * 3 * I_FFN + 2 * I_FIN + 2 * I_OUT + 2 * I_DIN + 2 * I_OUT;
        for (int it = gw; it < NITEMS; it += NGW) {
            int r = it;
            if (r < 8 * 3 * I_FFN) {
                const int f = r / (3 * I_FFN); r -= f * 3 * I_FFN; const int w3 = r / I_FFN; r -= w3 * I_FFN;
                bf16_t* gu = (bf16_t*)(ws + WS_W + (size_t)f * FFN_BLK);
                if (w3 == 0) conv_item(wg + (size_t)f * DM * FF, DM, FF, FF / 32, gu, 1, scr, r, lane);
                else if (w3 == 1) conv_item(wu + (size_t)f * DM * FF, DM, FF, FF / 32, gu, 2, scr, r, lane);
                else conv_item(wd + (size_t)f * FF * DM, FF, DM, DM / 32, (bf16_t*)(ws + WS_W + (size_t)f * FFN_BLK + FFN_DOWN_OFF), 0, scr, r, lane);
                continue;
            }
            r -= 8 * 3 * I_FFN;
            if (r < 2 * I_FIN) { const int j = r / I_FIN; r -= j * I_FIN; conv_item(fin + (size_t)j * DM * 3088, DM, 3088, 96, (bf16_t*)(ws + WS_FOXIN + (size_t)j * FOXIN_SZ), 3, scr, r, lane); continue; }
            r -= 2 * I_FIN;
            if (r < 2 * I_OUT) { const int j = r / I_OUT; r -= j * I_OUT; conv_item(fout + (size_t)j * DM * DM, DM, DM, 32, (bf16_t*)(ws + WS_FOXOUT + (size_t)j * OUT_SZ), 0, scr, r, lane); continue; }
            r -= 2 * I_OUT;
            if (r < 2 * I_DIN) { const int j = r / I_DIN; r -= j * I_DIN; conv_item(din + (size_t)j * DM * 9216, DM, 9216, 288, (bf16_t*)(ws + WS_DILIN + (size_t)j * DILIN_SZ), 3, scr, r, lane); continue; }
            r -= 2 * I_DIN;
            { const int j = r / I_OUT; r -= j * I_OUT; conv_item(dout + (size_t)j * DM * DM, DM, DM, 32, (bf16_t*)(ws + WS_DILOUT + (size_t)j * OUT_SZ), 0, scr, r, lane); }
        }
    }
}

template <bool FOX>
__device__ __forceinline__ void norm_phase(LAS unsigned char* lds, const float* xin, const float* g, const float* sc1p, const float* shift, bf16_t* hout,
                                           const float* wf_src, const float* bfv, float* cumloc, float* chtot) {
    const int tid = fresh_tid(), lane = tid & 63, wid = __builtin_amdgcn_readfirstlane(tid >> 6);
    const int G = gridDim.x;
    LAS float* wfL = (LAS float*)lds;
    if (FOX) {
        for (int k = tid; k < DM; k += NTHREADS) {
            const float* src = wf_src + (size_t)k * 3088;
#pragma unroll
            for (int q = 0; q < 4; ++q) { const f32x4 v = *(const f32x4*)(src + 4 * q);
#pragma unroll
                for (int e = 0; e < 4; ++e) wfL[(4 * q + e) * DM + k] = v[e]; }
        }
        __syncthreads();
    }
    for (int chunk = blockIdx.x; chunk < MT / 128; chunk += G) {
        const int b = chunk >> 5;
        const int row_base = chunk * 128 + wid * 16;
        f32x4 A[4], Bc[4];
#pragma unroll
        for (int j = 0; j < 4; ++j) {
            const int col = 4 * lane + 256 * j;
            A[j] = *(const f32x4*)(g + col) * *(const f32x4*)(sc1p + (size_t)b * MODN + col);
            Bc[j] = *(const f32x4*)(shift + (size_t)b * MODN + col);
        }
        float run = 0.f;
#pragma unroll 1
        for (int rg = 0; rg < 4; ++rg) {
            f32x4 hv[4][4];
#pragma unroll
            for (int rr = 0; rr < 4; ++rr) {
                const float* xr = xin + (size_t)(row_base + rg * 4 + rr) * DM + 4 * lane;
#pragma unroll
                for (int j = 0; j < 4; ++j) hv[rr][j] = *(const f32x4*)(xr + 256 * j);
            }
#pragma unroll
            for (int rr = 0; rr < 4; ++rr) {
                float ss = 0.f;
#pragma unroll
                for (int j = 0; j < 4; ++j) { const f32x4 t = hv[rr][j] * hv[rr][j]; ss += (t[0] + t[1]) + (t[2] + t[3]); }
                ss = wave_sum(ss);
                const float rstd = 1.0f / sqrtf(ss * (1.0f / DM) + 1e-6f);
                bf16_t* orow = hout + (size_t)(row_base + rg * 4 + rr) * DM + 4 * lane;
#pragma unroll
                for (int j = 0; j < 4; ++j) {
                    hv[rr][j] = hv[rr][j] * rstd * A[j] + Bc[j];
                    u32x2 w; w.x = pk2(hv[rr][j][0], hv[rr][j][1]); w.y = pk2(hv[rr][j][2], hv[rr][j][3]);
                    *(u32x2*)(orow + 256 * j) = w;
                }
            }
            if (FOX) {
                float zs[4] = {0.f, 0.f, 0.f, 0.f};
#pragma unroll 1
                for (int hh = 0; hh < 16; ++hh) {
                    f32x4 wv[4];
#pragma unroll
                    for (int j = 0; j < 4; ++j) wv[j] = *(const LAS f32x4*)(wfL + hh * DM + 4 * lane + 256 * j);
#pragma unroll
                    for (int rr = 0; rr < 4; ++rr) {
                        float s = 0.f;
#pragma unroll
                        for (int j = 0; j < 4; ++j) { const f32x4 t = hv[rr][j] * wv[j]; s += (t[0] + t[1]) + (t[2] + t[3]); }
                        s = wave_sum(s);
                        zs[rr] = ((lane & 15) == hh) ? s : zs[rr];
                    }
                }
                const float bfl = bfv[lane & 15];
                float* cp = cumloc + ((size_t)(b * NH + (lane & 15))) * SEQ + (chunk & 31) * 128 + wid * 16 + rg * 4;
#pragma unroll
                for (int rr = 0; rr < 4; ++rr) {
                    const float z = zs[rr] + bfl;
                    const float ls = -(fmaxf(-z, 0.f) + log1pf(__expf(-fabsf(z))));
                    run += ls;
                    if (lane < 16) cp[rr] = run;
                }
            }
        }
        if (FOX) { if (lane < 16) chtot[(b * NH + lane) * 256 + (chunk & 31) * 8 + wid] = run; }
    }
}

__device__ __forceinline__ void merge_phase(const bf16_t* qkv, const float* lse, bf16_t* hout) {
    const int tid = fresh_tid(), lane = tid & 63, wid = tid >> 6;
    const int gw = blockIdx.x * NWAVES + wid, NGW = gridDim.x * NWAVES;
    const int head = lane >> 2;
    for (int row = gw; row < MT / 2; row += NGW) {
        float ls[3], w[3];
#pragma unroll
        for (int g = 0; g < 3; ++g) ls[g] = lse[((size_t)row * 3 + g) * NH + head];
        const float mx = fmaxf(ls[0], fmaxf(ls[1], ls[2]));
        float sw = 0.f;
#pragma unroll
        for (int g = 0; g < 3; ++g) { w[g] = __builtin_amdgcn_exp2f(ls[g] - mx); sw += w[g]; }
        const float inv = 1.0f / sw;
        float acc[16];
#pragma unroll
        for (int e = 0; e < 16; ++e) acc[e] = 0.f;
#pragma unroll
        for (int g = 0; g < 3; ++g) {
            const u32x4* p = (const u32x4*)(qkv + (size_t)row * 9216 + g * 3072 + 16 * lane);
            const u32x4 v0 = p[0], v1 = p[1]; const float wg = w[g] * inv;
#pragma unroll
            for (int e = 0; e < 4; ++e) { acc[2 * e] += wg * bflo(v0[e]); acc[2 * e + 1] += wg * bfhi(v0[e]); acc[8 + 2 * e] += wg * bflo(v1[e]); acc[8 + 2 * e + 1] += wg * bfhi(v1[e]); }
        }
        u32x4 o0, o1;
#pragma unroll
        for (int e = 0; e < 4; ++e) { o0[e] = pk2(acc[2 * e], acc[2 * e + 1]); o1[e] = pk2(acc[8 + 2 * e], acc[8 + 2 * e + 1]); }
        u32x4* op = (u32x4*)(hout + (size_t)row * DM + 16 * lane);
        op[0] = o0; op[1] = o1;
    }
}

__device__ __forceinline__ void fox_attn_phase(int dry, LAS unsigned char* lds, bf16_t* Qb, const bf16_t* Kb, const bf16_t* Vb, const float* cumloc, const float* chtot) {
    const int tid = fresh_tid(), lane = tid & 63;
    const int G = gridDim.x;
    LAS float* dL = (LAS float*)(lds + fatt::D_OFF);
    LAS float* ctL = (LAS float*)(lds + fatt::CT_OFF);
    LAS float* pfL = (LAS float*)(lds + fatt::PFX_OFF);
    LAS float* wtL = (LAS float*)(lds + fatt::WT_OFF);
    for (int i = 0;; ++i) {
        const int id = i * G + blockIdx.x; if (id >= NB * NH * 16) break;
        const int bh = id & 127, jj = id >> 7, qb = jj ^ ((jj >> 1) & 1);
        __syncthreads();
        {
            float v = (tid < 256) ? chtot[bh * 256 + tid] : 0.f; const float own = v;
#pragma unroll
            for (int off = 1; off < 64; off <<= 1) { const float t = __shfl_up(v, off); if (lane >= off) v += t; }
            if (lane == 63 && tid < 256) wtL[tid >> 6] = v;
            __syncthreads();
            float pre = 0.f;
            for (int w = 0; w < (tid >> 6); ++w) pre += (w < 4) ? wtL[w] : 0.f;
            if (tid < 256) pfL[tid] = v - own + pre;
        }
        __syncthreads();
        const int nk = qb * 256 + 256;
        for (int s = tid; s < nk; s += NTHREADS) {
            const int se = s | 63;
            const float a = -(cumloc[(size_t)bh * SEQ + s] + pfL[s >> 4]) * LOG2E;
            const float c = -(cumloc[(size_t)bh * SEQ + se] + pfL[se >> 4]) * LOG2E;
            dL[s] = a - c;
            if (s == se) ctL[s >> 6] = c;
        }
        if (tid == 0) ctL[nk >> 6] = 0.f;
        __syncthreads();
        fatt::attn_unit<8>(bh >> 4, bh & 15, qb, (const fatt::bf16*)Qb, (const fatt::bf16*)Kb, (const fatt::bf16*)Vb, (fatt::bf16*)Qb, (char*)(unsigned char*)lds);
    }
}
__device__ __forceinline__ void dil_attn_phase(int dry, LAS unsigned char* lds, bf16_t* qkv, float* lse) {
    const int G = gridDim.x;
    for (int i = 0;; ++i) {
        const int id = i * G + blockIdx.x; if (id >= 4 * NH * 48) break;
        const int sub = id & 15, g = (id >> 4) % 3, h = (id / 48) & 15, bl = id / 768;
        int d, rho, blk;
        if (g == 0) { d = 1; rho = 0; blk = sub; } else if (g == 1) { d = 4; rho = sub >> 2; blk = sub & 3; } else { d = 16; rho = sub; blk = 0; }
        __syncthreads();
        att::Unit U;
        const size_t rowl = (size_t)bl * SEQ + rho;
        bf16_t* qp = qkv + rowl * 9216 + (size_t)g * 3072 + h * 64;
        U.Q = qp; U.K = qp + 1024; U.V = qp + 2048; U.O = qp; U.stride = (long)d * 9216;
        U.q0 = blk * 256; U.t_lo = (4 * blk - 2 > 0) ? 4 * blk - 2 : 0; U.t_hi = 4 * blk + 4; U.window = 128; U.bias = 0; U.dry = dry;
        U.lse = lse + (rowl * 3 + g) * NH + h; U.lse_stride = (long)d * 48;
        att::unit_run(lds, U);
    }
}

#define XB_TMO      128
#define XB_XCNT(j)  (256  + 64 * (j))
#define XB_XSUB(j)  (1280 + 64 * (j))
#define XB_XGEN(j)  (2304 + 64 * (j))
#define XB_TOP      3328
#define XB_TOPGEN   3392
#define XCD_BAR_WORDS 3456
#define XB_SPIN_CAP (1u << 18)

__device__ __forceinline__ unsigned xb_ld(unsigned* p)              { return __hip_atomic_load(p, __ATOMIC_RELAXED, __HIP_MEMORY_SCOPE_AGENT); }
__device__ __forceinline__ unsigned xb_add(unsigned* p, unsigned v) { return __hip_atomic_fetch_add(p, v, __ATOMIC_RELAXED, __HIP_MEMORY_SCOPE_AGENT); }
__device__ __forceinline__ unsigned xb_xcc_id() { return (unsigned)__builtin_amdgcn_s_getreg((3 << 11) | 20) & 0xFu; }
#define XB_SPIN(cond, bar) do { unsigned _sp = 0; while (cond) { __builtin_amdgcn_s_sleep(1); \
    if ((++_sp & 255u) == 0u) { if (xb_ld(&(bar)[XB_TMO])) break; if (_sp > XB_SPIN_CAP) { atomicAdd(&(bar)[XB_TMO], 1u); break; } } } } while (0)

struct XcdBarrier {
    unsigned* bar; unsigned x;
    volatile LAS unsigned* st;
};

__device__ __forceinline__ XcdBarrier xcd_barrier_post(unsigned* bar, volatile LAS unsigned* st) {
    XcdBarrier b; b.bar = bar; b.x = xb_xcc_id(); b.st = st;
    if (threadIdx.x == 0) (void)xb_add(&bar[XB_XCNT(b.x)], 1u);
    return b;
}
__device__ __forceinline__ void xcd_barrier_complete(unsigned* bar, unsigned x, unsigned& nloc, unsigned& nx) {
    const unsigned G = gridDim.x * gridDim.y * gridDim.z;
    unsigned sum, cnt, mine, sp = 0u;
    for (;;) {
        sum = 0u; cnt = 0u; mine = 0u;
#pragma unroll
        for (unsigned j = 0; j < 16; ++j) { const unsigned c = xb_ld(&bar[XB_XCNT(j)]); sum += c; cnt += (c > 0u) ? 1u : 0u; mine = (j == x) ? c : mine; }
        if (sum == G) break;
        __builtin_amdgcn_s_sleep(1);
        if ((++sp & 255u) == 0u) { if (xb_ld(&bar[XB_TMO])) break; if (sp > XB_SPIN_CAP) { atomicAdd(&bar[XB_TMO], 1u); break; } }
    }
    nloc = mine > 0u ? mine : 1u; nx = cnt > 0u ? cnt : 1u;
}

__device__ __forceinline__ void xcd_barrier(const XcdBarrier& b) {
    asm volatile("s_waitcnt vmcnt(0)" ::: "memory");
    __syncthreads();
    if (threadIdx.x == 0) {
        unsigned* bar = b.bar;
        __builtin_amdgcn_s_waitcnt(0);
        unsigned nloc = b.st[0], nx = b.st[1];
        if (nloc == 0u) { xcd_barrier_complete(bar, b.x, nloc, nx); b.st[0] = nloc; b.st[1] = nx; }
        const unsigned old = xb_add(&bar[XB_XSUB(b.x)], 1u);
        const unsigned gen = old / nloc;
        if (old + 1u == (gen + 1u) * nloc) {
            __builtin_amdgcn_fence(__ATOMIC_RELEASE, "agent");
            asm volatile("s_waitcnt vmcnt(0)" ::: "memory");
            const unsigned og = xb_add(&bar[XB_TOP], 1u);
            const unsigned tg = og / nx;
            if (og + 1u == (tg + 1u) * nx) xb_add(&bar[XB_TOPGEN], 1u);
            else XB_SPIN(xb_ld(&bar[XB_TOPGEN]) == tg, bar);
            __builtin_amdgcn_fence(__ATOMIC_ACQUIRE, "agent");
            xb_add(&bar[XB_XGEN(b.x)], 1u);
            asm volatile("s_waitcnt vmcnt(0)" ::: "memory");
        } else {
            XB_SPIN(xb_ld(&bar[XB_XGEN(b.x)]) == gen, bar);
            __builtin_amdgcn_fence(__ATOMIC_ACQUIRE, "agent");
            asm volatile("s_waitcnt vmcnt(0)" ::: "memory");
        }
    }
    __syncthreads();
}

#ifndef PMASK
#define PMASK 255
#endif
enum { OP_NORM = 0, OP_GU = 1, OP_DOWN = 2, OP_QKV = 3, OP_ATT = 4, OP_OUT = 5, OP_PROJ = 6, OP_DATT = 7, OP_MERGE = 8 };
constexpr int N_PHASES = 1 + 2 * 10 + 2 * 14;

typedef const Args __attribute__((address_space(4))) CArgs;
__device__ __forceinline__ CArgs& fresh_args() { unsigned long long p = (unsigned long long)__builtin_amdgcn_kernarg_segment_ptr(); asm volatile("" : "+s"(p)); return *(CArgs*)p; }
__device__ __forceinline__ void run_phase(LAS unsigned char* lds, int ph, int dry) {
    CArgs& a = fresh_args();
    if (ph == 0) { if (PMASK & 1) prologue_phase(a, lds); return; }
    int p = ph - 1, layer = 0, n;
    for (;;) { n = (layer & 1) ? 14 : 10; if (p < n) break; p -= n; ++layer; }
    const bool dil = (layer & 1) != 0; const int j = layer >> 1;
    int op, sub, hb = 0, ffn = 0;
    if (p < 3) { sub = 0; ffn = 0; op = p; }
    else if (p >= n - 3) { sub = 2; ffn = 1; op = p - (n - 3); }
    else { sub = 1; const int q = p - 3;
        if (!dil) op = (q == 0) ? OP_NORM : (q == 1) ? OP_QKV : (q == 2) ? OP_ATT : OP_OUT;
        else if (q == 0) op = OP_NORM; else if (q == 7) op = OP_OUT; else { hb = (q - 1) / 3; const int r = (q - 1) % 3; op = (r == 0) ? OP_PROJ : (r == 1) ? OP_DATT : OP_MERGE; } }
    unsigned char* ws = a.ws;
    const float* x0 = (const float*)a.in[0];
    float* xo = a.out;
    const bool first = (layer == 0 && sub == 0);
    const float* xin = first ? x0 : (const float*)xo;
    const float* modl = (const float*)(ws + WS_MOD) + (size_t)layer * NB * MODN + (size_t)sub * 3 * DM;
    bf16_t* HB = (bf16_t*)(ws + WS_H);
    bf16_t* BIG = (bf16_t*)(ws + WS_BIG);
    const int G = gridDim.x, bid = blockIdx.x;
    const int f = layer * 2 + ffn;
    if (op == OP_NORM && (PMASK & 2)) {
        const float* g = (const float*)a.in[5] + (size_t)(layer * 3 + sub) * DM;
        if (sub == 1 && !dil)
            norm_phase<true>(lds, xin, g, modl + DM, modl, HB, (const float*)a.in[9] + (size_t)j * DM * 3088 + 3072, (const float*)a.in[10] + j * NH, (float*)(ws + WS_CUM), (float*)(ws + WS_CHT));
        else
            norm_phase<false>(lds, xin, g, modl + DM, modl, HB, nullptr, nullptr, nullptr, nullptr);
    } else if ((op == OP_GU || op == OP_DOWN || op == OP_OUT || op == OP_QKV || op == OP_PROJ) && (PMASK & 4)) {
        pg8::Gemm gm; pg8::StaticOrder S; pg8::EpiAny E;
        E.kind = 0; E.s.Hd = BIG; E.r.xin = xin; E.r.xout = xo; E.r.coef = modl + 2 * DM;
        E.q.out = BIG; E.q.fox = 1; E.q.qg = nullptr; E.q.kg = nullptr; E.q.cs = nullptr; E.q.sn = nullptr;
        if (op == OP_GU) { gm = pg8::Gemm{HB, (const bf16_t*)(ws + WS_W + (size_t)f * FFN_BLK), MT, 2 * FF, DM}; E.kind = 0; }
        else if (op == OP_DOWN) { gm = pg8::Gemm{BIG, (const bf16_t*)(ws + WS_W + (size_t)f * FFN_BLK + FFN_DOWN_OFF), MT, DM, FF}; E.kind = 1; }
        else if (op == OP_OUT) { E.kind = 1;
            if (!dil) gm = pg8::Gemm{BIG, (const bf16_t*)(ws + WS_FOXOUT + (size_t)j * OUT_SZ), MT, DM, DM};
            else gm = pg8::Gemm{HB, (const bf16_t*)(ws + WS_DILOUT + (size_t)j * OUT_SZ), MT, DM, DM}; }
        else if (op == OP_QKV) { E.kind = 2;
            gm = pg8::Gemm{HB, (const bf16_t*)(ws + WS_FOXIN + (size_t)j * FOXIN_SZ), MT, 3072, DM};
            E.q.qg = (const float*)a.in[11] + j * 64; E.q.kg = (const float*)a.in[12] + j * 64; }
        else { E.kind = 2; E.q.fox = 0;
            gm = pg8::Gemm{HB + (size_t)hb * (MT / 2) * DM, (const bf16_t*)(ws + WS_DILIN + (size_t)j * DILIN_SZ), MT / 2, 9216, DM};
            E.q.qg = (const float*)a.in[15] + j * 192; E.q.kg = (const float*)a.in[16] + j * 192;
            E.q.cs = (const float*)(ws + WS_COS) + (size_t)hb * (MT / 2) * 8; E.q.sn = (const float*)(ws + WS_SIN) + (size_t)hb * (MT / 2) * 8; }
        if (dry) E.kind = 3;
        S.init(gm.M, gm.N, G, bid);
        pg8::gemm_phase<pg8::EpiAny, pg8::StaticOrder, true, true>(lds, gm, S, E);
    } else if (op == OP_ATT && (PMASK & 32)) {
        fox_attn_phase(dry, lds, BIG, BIG + (size_t)MT * DM, BIG + (size_t)2 * MT * DM, (const float*)(ws + WS_CUM), (const float*)(ws + WS_CHT));
    } else if (op == OP_DATT && (PMASK & 64)) {
        dil_attn_phase(dry, lds, BIG, (float*)(ws + WS_LSE));
    } else if (op == OP_MERGE && (PMASK & 128)) {
        merge_phase(BIG, (const float*)(ws + WS_LSE), HB + (size_t)hb * (MT / 2) * DM);
    }
}

#ifndef REP_MASK
#define REP_MASK 0
#endif
#ifndef SYNC_REP
#define SYNC_REP 1
#endif
__device__ __forceinline__ int phase_op(int ph) {
    if (ph == 0) return 9;
    int p = ph - 1, layer = 0, n;
    for (;;) { n = (layer & 1) ? 14 : 10; if (p < n) break; p -= n; ++layer; }
    if (p < 3) return p;
    if (p >= n - 3) return p - (n - 3);
    const int q = p - 3;
    if (!(layer & 1)) return (q == 0) ? OP_NORM : (q == 1) ? OP_QKV : (q == 2) ? OP_ATT : OP_OUT;
    if (q == 0) return OP_NORM; if (q == 7) return OP_OUT;
    const int r = (q - 1) % 3; return (r == 0) ? OP_PROJ : (r == 1) ? OP_DATT : OP_MERGE;
}
#ifndef MK_COOP
#define MK_COOP 1
#endif

__global__ void __launch_bounds__(NTHREADS, 2) mk_fwd(Args a) {
    extern __shared__ __attribute__((aligned(16))) unsigned char lds_raw[];
    LAS unsigned char* lds = (LAS unsigned char*)lds_raw;
    volatile LAS unsigned* misc = (volatile LAS unsigned*)(lds + LDS_BYTES - 64);
    if (threadIdx.x < 16) misc[threadIdx.x] = 0u;
    __syncthreads();
    XcdBarrier bar = xcd_barrier_post((unsigned*)(fresh_args().ws + WS_BAR), misc);
    const int lo = fresh_args().ph_lo;
    for (int ph = lo;; ++ph) {
#if REP_MASK
        const int nrep = ((REP_MASK >> phase_op(ph)) & 1) ? 2 : 1;
        for (int rep = 0; rep < nrep; ++rep) { run_phase(lds, ph, (rep + 1 < nrep) ? 1 : 0); __syncthreads(); }
#else
        run_phase(lds, ph, 0);
#endif
        if (ph + 1 >= fresh_args().ph_hi) break;
        for (int sr = 0; sr < SYNC_REP; ++sr) { if (ph == lo) cg::this_grid().sync(); else xcd_barrier(bar); }
    }
}

extern "C" void kernel_launch(void* const* d_in, const int* in_sizes, int n_in, void* d_out, int out_size, void* d_ws, size_t ws_size, hipStream_t stream) {
    static int grid = 0;
    if (grid == 0) {
        if (n_in != 18 || out_size != MT * DM || ws_size < WS_END) { fprintf(stderr, "kernel_launch: unexpected shapes (n_in %d, out %d, ws %zu; need ws >= %zu)\n", n_in, out_size, ws_size, (size_t)WS_END); grid = -1; return; }
        int dev = 0, cus = 0, per_cu = 0;
        if (hipGetDevice(&dev) != hipSuccess || hipDeviceGetAttribute(&cus, hipDeviceAttributeMultiprocessorCount, dev) != hipSuccess) { grid = -1; return; }
        if (hipFuncSetAttribute((const void*)mk_fwd, hipFuncAttributeMaxDynamicSharedMemorySize, LDS_BYTES) != hipSuccess) { fprintf(stderr, "kernel_launch: hipFuncSetAttribute failed\n"); grid = -1; return; }
        if (hipOccupancyMaxActiveBlocksPerMultiprocessor(&per_cu, (const void*)mk_fwd, NTHREADS, LDS_BYTES) != hipSuccess || per_cu < 1) { per_cu = 1; (void)hipGetLastError(); }
        grid = cus * per_cu;
    }
    if (grid < 0) return;
    Args a{};
    for (int i = 0; i < 18; ++i) a.in[i] = d_in[i];
    a.out = (float*)d_out; a.ws = (unsigned char*)d_ws;
#if MK_COOP
    if (hipMemsetAsync((char*)d_ws + WS_BAR, 0, WS_BAR_BYTES, stream) != hipSuccess) { fprintf(stderr, "kernel_launch: memset failed\n"); return; }
    a.ph_lo = 0; a.ph_hi = N_PHASES;
    void* args[] = {&a};
    hipError_t e = hipLaunchCooperativeKernel((const void*)mk_fwd, dim3(grid), dim3(NTHREADS), args, LDS_BYTES, stream);
    if (e != hipSuccess) fprintf(stderr, "cooperative launch failed: %s (grid %d)\n", hipGetErrorString(e), grid);
#else
    for (int ph = 0; ph < N_PHASES; ++ph) {
        a.ph_lo = ph; a.ph_hi = ph + 1;
        hipLaunchKernelGGL(mk_fwd, dim3(grid), dim3(NTHREADS), LDS_BYTES, stream, a);
    }
#endif
}
```

```cpp
#include <hip/hip_runtime.h>
#include <hip/hip_cooperative_groups.h>
#include <hip/hip_bf16.h>
#include <cstdio>
#include <cstdint>
#include <cmath>
namespace cg = cooperative_groups;
namespace pg8 {
#define PG8_LAS __attribute__((address_space(3)))
typedef unsigned short bf16_t;
typedef short bf16x8 __attribute__((ext_vector_type(8)));
typedef float f32x4 __attribute__((ext_vector_type(4)));
typedef unsigned u32x4 __attribute__((ext_vector_type(4)));
constexpr int BM = 256, BK = 64, HALF = 128, HTB = HALF * BK * 2  , STAGE_BYTES = 8 * HTB, NXCD = 8, WGM = 8;

__host__ __device__ __forceinline__ int lds_byte(int r, int c) { const int st = (r >> 4) * 2 + (c >> 5), rr = r & 15, cc = c & 31, ob = rr * 64 + cc * 2; return st * 1024 + (ob ^ (((ob >> 9) & 1) << 5)); }
__host__ __device__ __forceinline__ void stage_rc(int b, int& R, int& C) { const int st = b / 1024, sb = b % 1024, swz = sb ^ (((sb >> 9) & 1) << 5); R = (st >> 1) * 16 + swz / 64; C = (st & 1) * 32 + (swz % 64) / 2; }
__host__ __device__ __forceinline__ int perm32(int rho) { const int n = rho >> 4, i = rho & 15; return 8 * (i >> 2) + 4 * n + (i & 3); }

struct Unit { int pm, pn; };
struct Gemm { const bf16_t* A; const bf16_t* Bt; int M, N, K; };

struct StaticOrder {
    int nM, nN, nwg, G, c;
    __host__ __device__ void init(int M, int N, int G_, int c_) { nM = M / BM; nN = N / BM; nwg = nM * nN; G = G_; c = c_; }
    __host__ __device__ bool next(int i, Unit& u) const {
        const long L = (long)i * G + c; if (L >= nwg) return false;
        int wgid = (int)L; { const int q = nwg / NXCD, r = nwg % NXCD, xcd = wgid % NXCD, off = wgid / NXCD; wgid = (xcd < r ? xcd * (q + 1) : r * (q + 1) + (xcd - r) * q) + off; }
        const int nig = WGM * nN, gid = wgid / nig, fm = gid * WGM, gsz = (nM - fm) < WGM ? (nM - fm) : WGM;
        u.pm = fm + ((wgid % nig) % gsz); u.pn = (wgid % nig) / gsz; return true;
    }
    __device__ __forceinline__ void a_ready(const Unit&) const {}
    __device__ __forceinline__ void done(const Unit&) const {}
};

__device__ __forceinline__ unsigned cvt_pk_bf16(float lo, float hi) { unsigned r; asm volatile("v_cvt_pk_bf16_f32 %0, %1, %2" : "=v"(r) : "v"(lo), "v"(hi)); return r; }
typedef float f32x2 __attribute__((ext_vector_type(2)));
constexpr int P_MT = 32768, P_DM = 1024, P_FF = 2816, P_MODN = 9216;
constexpr float P_C2 = 0.125f * 1.4426950408889634f;

struct EpiSwiGLU {
    static constexpr bool PERM = true, AFTER_DRAIN = false;
    bf16_t* Hd;
    __device__ __forceinline__ void operator()(const f32x4 (&acc)[2][2][4][2], const Unit& u, int wr, int wc, int fr, int fq) const {
        const int row0 = u.pm * BM + wr * 64 + fr, col0 = u.pn * 128 + wc * 32 + 8 * fq;
#pragma unroll
        for (int ai = 0; ai < 2; ++ai)
#pragma unroll
            for (int m = 0; m < 4; ++m) {
                bf16_t* rowp = Hd + (size_t)(row0 + ai * HALF + m * 16) * P_FF + col0;
                float v[8];
#pragma unroll
                for (int n = 0; n < 2; ++n)
#pragma unroll
                    for (int e = 0; e < 4; ++e) {
                        const float g = acc[ai][0][m][n][e], up = acc[ai][1][m][n][e];
                        const float s = __builtin_amdgcn_rcpf(1.0f + __builtin_amdgcn_exp2f(-1.4426950408889634f * g));
                        v[n * 4 + e] = g * s * up;
                    }
                u32x4 w; w.x = cvt_pk_bf16(v[0], v[1]); w.y = cvt_pk_bf16(v[2], v[3]); w.z = cvt_pk_bf16(v[4], v[5]); w.w = cvt_pk_bf16(v[6], v[7]);
                *(u32x4*)rowp = w;
            }
    }
};

typedef _Float16 h16x2 __attribute__((ext_vector_type(2)));
__device__ __forceinline__ unsigned pk_f16(float lo, float hi) { h16x2 v; v[0] = (_Float16)lo; v[1] = (_Float16)hi; return __builtin_bit_cast(unsigned, v); }
__device__ __forceinline__ float f16lo(unsigned w) { return (float)__builtin_bit_cast(h16x2, w)[0]; }
__device__ __forceinline__ float f16hi(unsigned w) { return (float)__builtin_bit_cast(h16x2, w)[1]; }
struct EpiResid {
    static constexpr bool PERM = true, AFTER_DRAIN = false;
    const void* xin; void* xout; const float* coef; int in_bf16, out_bf16;
    __device__ __forceinline__ void operator()(const f32x4 (&acc)[2][2][4][2], const Unit& u, int wr, int wc, int fr, int fq) const {
        const int row0 = u.pm * BM + wr * 64 + fr, col0 = u.pn * BM + wc * 32 + 8 * fq;
        const float* cf = coef + (size_t)(u.pm >> 4) * P_MODN + col0;
        f32x4 cv[2][2];
#pragma unroll
        for (int bj = 0; bj < 2; ++bj)
#pragma unroll
            for (int n = 0; n < 2; ++n) cv[bj][n] = *(const f32x4*)(cf + bj * HALF + n * 4);
        if (in_bf16) {
#pragma unroll
            for (int ai = 0; ai < 2; ++ai) {
                u32x4 raw[4][2];
#pragma unroll
                for (int m = 0; m < 4; ++m) {
                    const size_t off = (size_t)(row0 + ai * HALF + m * 16) * P_DM + col0;
#pragma unroll
                    for (int bj = 0; bj < 2; ++bj) raw[m][bj] = *(const u32x4*)((const bf16_t*)xin + off + bj * HALF);
                }
                asm volatile("" ::: "memory");
#pragma unroll
                for (int m = 0; m < 4; ++m) {
                    const size_t off = (size_t)(row0 + ai * HALF + m * 16) * P_DM + col0;
#pragma unroll
                    for (int bj = 0; bj < 2; ++bj) {
                        const u32x4 w = raw[m][bj];
                        const f32x4 x0 = (f32x4){f16lo(w.x), f16hi(w.x), f16lo(w.y), f16hi(w.y)};
                        const f32x4 x1 = (f32x4){f16lo(w.z), f16hi(w.z), f16lo(w.w), f16hi(w.w)};
                        const f32x4 v0 = x0 + cv[bj][0] * acc[ai][bj][m][0], v1 = x1 + cv[bj][1] * acc[ai][bj][m][1];
                        if (out_bf16) {
                            u32x4 o; o.x = pk_f16(v0[0], v0[1]); o.y = pk_f16(v0[2], v0[3]); o.z = pk_f16(v1[0], v1[1]); o.w = pk_f16(v1[2], v1[3]);
                            *(u32x4*)((bf16_t*)xout + off + bj * HALF) = o;
                        } else {
                            *(f32x4*)((float*)xout + off + bj * HALF) = v0; *(f32x4*)((float*)xout + off + bj * HALF + 4) = v1;
                        }
                    }
                }
            }
        } else {
#pragma unroll
            for (int ai = 0; ai < 2; ++ai)
#pragma unroll
                for (int m = 0; m < 4; ++m) {
                    const size_t off = (size_t)(row0 + ai * HALF + m * 16) * P_DM + col0;
#pragma unroll
                    for (int bj = 0; bj < 2; ++bj) {
                        const f32x4 x0 = *(const f32x4*)((const float*)xin + off + bj * HALF), x1 = *(const f32x4*)((const float*)xin + off + bj * HALF + 4);
                        const f32x4 v0 = x0 + cv[bj][0] * acc[ai][bj][m][0], v1 = x1 + cv[bj][1] * acc[ai][bj][m][1];
                        u32x4 o; o.x = pk_f16(v0[0], v0[1]); o.y = pk_f16(v0[2], v0[3]); o.z = pk_f16(v1[0], v1[1]); o.w = pk_f16(v1[2], v1[3]);
                        *(u32x4*)((bf16_t*)xout + off + bj * HALF) = o;
                    }
                }
        }
    }
};

struct EpiQKV {
    static constexpr bool PERM = true, AFTER_DRAIN = false;
    bf16_t* out; int fox; const float* qg; const float* kg; const float* cs; const float* sn;
    __device__ __forceinline__ void operator()(const f32x4 (&acc)[2][2][4][2], const Unit& u, int wr, int wc, int fr, int fq) const {
        int which, colbase, pitch; bf16_t* base; const float* gq; const float* gk;
        if (fox) { which = u.pn >> 2; base = out + (size_t)which * ((size_t)P_MT * P_DM); pitch = P_DM; colbase = (u.pn & 3) * 256; gq = qg; gk = kg; }
        else { const int grp = u.pn / 12; which = (u.pn % 12) >> 2; base = out; pitch = 9216; colbase = u.pn * 256; gq = qg + grp * 64; gk = kg + grp * 64; }
        const int row0 = u.pm * BM + wr * 64 + fr;
        const int cw = colbase + wc * 64 + 8 * fq;
        if (which == 2) {
#pragma unroll
            for (int ai = 0; ai < 2; ++ai)
#pragma unroll
                for (int m = 0; m < 4; ++m) {
                    bf16_t* rowp = base + (size_t)(row0 + ai * HALF + m * 16) * pitch + cw;
#pragma unroll
                    for (int bj = 0; bj < 2; ++bj) {
                        const f32x4 v0 = acc[ai][bj][m][0], v1 = acc[ai][bj][m][1];
                        u32x4 w; w.x = cvt_pk_bf16(v0[0], v0[1]); w.y = cvt_pk_bf16(v0[2], v0[3]); w.z = cvt_pk_bf16(v1[0], v1[1]); w.w = cvt_pk_bf16(v1[2], v1[3]);
                        *(u32x4*)(rowp + bj * 32) = w;
                    }
                }
        } else {
            const float* gp = (which == 0) ? gq : gk; const float osc = (which == 0) ? P_C2 : 1.0f;
            f32x4 gv[2][2];
#pragma unroll
            for (int bj = 0; bj < 2; ++bj)
#pragma unroll
                for (int n = 0; n < 2; ++n) gv[bj][n] = *(const f32x4*)(gp + 32 * bj + 8 * fq + 4 * n) * osc;
            f32x4 rc[2], rs[2];
            if (!fox) {
#pragma unroll
                for (int n = 0; n < 2; ++n) { rc[n] = *(const f32x4*)(cs + (size_t)row0 * 8 + 4 * n); rs[n] = *(const f32x4*)(sn + (size_t)row0 * 8 + 4 * n); }
            }
#pragma unroll
            for (int ai = 0; ai < 2; ++ai)
#pragma unroll
                for (int m = 0; m < 4; ++m) {
                    const int row = row0 + ai * HALF + m * 16;
                    f32x4 v[2][2]; float ss = 0.f;
#pragma unroll
                    for (int bj = 0; bj < 2; ++bj)
#pragma unroll
                        for (int n = 0; n < 2; ++n) { v[bj][n] = acc[ai][bj][m][n]; const f32x4 t = v[bj][n] * v[bj][n]; ss += (t[0] + t[1]) + (t[2] + t[3]); }
                    ss += __shfl_xor(ss, 16); ss += __shfl_xor(ss, 32);
                    const float rstd = 1.0f / sqrtf(ss * (1.0f / 64.0f) + 1e-6f);
#pragma unroll
                    for (int bj = 0; bj < 2; ++bj)
#pragma unroll
                        for (int n = 0; n < 2; ++n) v[bj][n] = v[bj][n] * rstd * gv[bj][n];
                    if (!fox) {
                        f32x4 c[2], s[2];
#pragma unroll
                        for (int n = 0; n < 2; ++n) { c[n] = rc[n]; s[n] = rs[n]; }
                        if (!(ai == 1 && m == 3)) {
                            const int nrow = row0 + ((ai * 4 + m + 1) >> 2) * HALF + ((m + 1) & 3) * 16;
#pragma unroll
                            for (int n = 0; n < 2; ++n) { rc[n] = *(const f32x4*)(cs + (size_t)nrow * 8 + 4 * n); rs[n] = *(const f32x4*)(sn + (size_t)nrow * 8 + 4 * n); }
                            asm volatile("" ::: "memory");
                        }
#pragma unroll
                        for (int n = 0; n < 2; ++n) {
                            f32x4 oth;
#pragma unroll
                            for (int e = 0; e < 4; ++e) oth[e] = __shfl_xor(v[0][n][e], 16);
                            const f32x4 r0 = v[0][n] * c[n] - oth * s[n], r1 = v[0][n] * c[n] + oth * s[n];
                            v[0][n] = (fq == 0) ? r0 : ((fq == 1) ? r1 : v[0][n]);
                        }
                    }
                    bf16_t* rowp = base + (size_t)row * pitch + cw;
#pragma unroll
                    for (int bj = 0; bj < 2; ++bj) {
                        const f32x4 v0 = v[bj][0], v1 = v[bj][1];
                        u32x4 w; w.x = cvt_pk_bf16(v0[0], v0[1]); w.y = cvt_pk_bf16(v0[2], v0[3]); w.z = cvt_pk_bf16(v1[0], v1[1]); w.w = cvt_pk_bf16(v1[2], v1[3]);
                        *(u32x4*)(rowp + bj * 32) = w;
                    }
                }
        }
    }
};

struct EpiAny {
    static constexpr bool PERM = true, AFTER_DRAIN = false;
    int kind; EpiSwiGLU s; EpiResid r; EpiQKV q;
    __device__ __forceinline__ void operator()(const f32x4 (&acc)[2][2][4][2], const Unit& u, int wr, int wc, int fr, int fq) const {
        if (kind == 0) s(acc, u, wr, wc, fr, fq); else if (kind == 1) r(acc, u, wr, wc, fr, fq); else if (kind == 2) q(acc, u, wr, wc, fr, fq);
    }
};
template <class Epi, class Sched, bool ALIGN_EPI = false, bool SP2 = false>
__device__ __forceinline__ void gemm_phase(PG8_LAS unsigned char* lds, const Gemm g, const Sched& S, const Epi& E) {
    int tid_ = threadIdx.x; asm volatile("" : "+v"(tid_)); const int tid = tid_, wid = __builtin_amdgcn_readfirstlane(tid >> 6), lane = tid & 63, wr = wid >> 2, wc = wid & 3, fr = lane & 15, fq = lane >> 4;
    const int K = g.K, nt = K / BK;
    unsigned voffA[2], voffB[2];
#pragma unroll
    for (int i = 0; i < 2; ++i) { int R, C; stage_rc(tid * 16 + i * 8192, R, C); const int Rb = Epi::PERM ? ((R & ~31) + perm32(R & 31)) : R;
        voffA[i] = (unsigned)(R * K + C) * 2u; voffB[i] = (unsigned)(Rb * K + C) * 2u; }
    const size_t kstep = (size_t)(BK * 2);
    const size_t hstep = (size_t)HALF * K * 2;
    const size_t tstep = 2 * hstep;
    const unsigned ldsw = (unsigned)wid * 1024u;
    const int aoff = lds_byte(wr * 64 + fr, fq * 8), boff = lds_byte(wc * 32 + fr, fq * 8);
#define PG8_SA(b, h) (((b) * 2 + (h)) * HTB)
#define PG8_SB(b, h) ((4 + (b) * 2 + (h)) * HTB)
#define PG8_STAGE(bufoff, gbase, voff) do { _Pragma("unroll") for (int _i = 0; _i < 2; ++_i) \
        __builtin_amdgcn_global_load_lds((const unsigned*)((const char*)(gbase) + (voff)[_i]), (PG8_LAS unsigned*)(lds + (bufoff) + ldsw + _i * 8192), 16, 0, 0); } while (0)
#define PG8_LDA(dst, b, h) do { _Pragma("unroll") for (int m = 0; m < 4; ++m) _Pragma("unroll") for (int k = 0; k < 2; ++k) dst[m][k] = *(const PG8_LAS bf16x8*)(lds + PG8_SA(b, h) + aoff + m * 2048 + k * 1024); } while (0)
#define PG8_LDB(dst, b, h) do { _Pragma("unroll") for (int n = 0; n < 2; ++n) _Pragma("unroll") for (int k = 0; k < 2; ++k) dst[n][k] = *(const PG8_LAS bf16x8*)(lds + PG8_SB(b, h) + boff + n * 2048 + k * 1024); } while (0)
#define PG8_MMA(ai, bj, At, Bt) do { __builtin_amdgcn_s_setprio(1); _Pragma("unroll") for (int m = 0; m < 4; ++m) _Pragma("unroll") for (int n = 0; n < 2; ++n) _Pragma("unroll") for (int k = 0; k < 2; ++k) \
        acc[ai][bj][m][n] = __builtin_amdgcn_mfma_f32_16x16x32_bf16(Bt[n][k], At[m][k], acc[ai][bj][m][n], 0, 0, 0); __builtin_amdgcn_s_setprio(0); } while (0)
#define PG8_WAIT_V(n) asm volatile("s_waitcnt vmcnt(" #n ")" ::: "memory")
#define PG8_WAIT_L(n) asm volatile("s_waitcnt lgkmcnt(" #n ")" ::: "memory")
#define PG8_BAR __builtin_amdgcn_s_barrier()
#define PG8_SCHED __builtin_amdgcn_sched_barrier(0)
    Unit cur, nxt; int ui = 0;
    if (!S.next(0, cur)) return;
    f32x4 acc[2][2][4][2];
#pragma unroll
    for (int a = 0; a < 2; ++a)
#pragma unroll
        for (int b = 0; b < 2; ++b)
#pragma unroll
            for (int m = 0; m < 4; ++m)
#pragma unroll
                for (int n = 0; n < 2; ++n) acc[a][b][m][n] = (f32x4){0.f, 0.f, 0.f, 0.f};
    bf16x8 At[4][2], B0[2][2], B1[2][2];
    const char* cA = (const char*)g.A + (size_t)cur.pm * tstep; const char* cB = (const char*)g.Bt + (size_t)cur.pn * tstep;
    S.a_ready(cur);
    if constexpr (SP2) {
        PG8_STAGE(PG8_SB(0, 0), cB, voffB); PG8_STAGE(PG8_SB(0, 1), cB + hstep, voffB); PG8_STAGE(PG8_SA(0, 0), cA, voffA); PG8_STAGE(PG8_SA(0, 1), cA + hstep, voffA);
        if (wr == 1) PG8_BAR;
        PG8_WAIT_V(2); PG8_BAR;
        PG8_STAGE(PG8_SB(1, 0), cB + kstep, voffB); PG8_STAGE(PG8_SA(1, 0), cA + kstep, voffA); PG8_STAGE(PG8_SB(1, 1), cB + hstep + kstep, voffB);
        PG8_WAIT_V(6); PG8_BAR;
    } else {
        PG8_STAGE(PG8_SB(0, 0), cB, voffB); PG8_STAGE(PG8_SA(0, 0), cA, voffA); PG8_STAGE(PG8_SB(0, 1), cB + hstep, voffB); PG8_STAGE(PG8_SA(0, 1), cA + hstep, voffA);
        if (wr == 1) PG8_BAR;
        PG8_WAIT_V(4); PG8_BAR;
        PG8_STAGE(PG8_SB(1, 0), cB + kstep, voffB); PG8_STAGE(PG8_SA(1, 0), cA + kstep, voffA); PG8_STAGE(PG8_SB(1, 1), cB + hstep + kstep, voffB);
        PG8_WAIT_V(6); PG8_BAR;
    }
    for (;;) {
        const bool has_next = S.next(ui + 1, nxt);
        const char* nA = has_next ? (const char*)g.A + (size_t)nxt.pm * tstep : cA; const char* nB = has_next ? (const char*)g.Bt + (size_t)nxt.pn * tstep : cB;
        for (int t = 0; t < nt; t += 2) {
            const bool last = (t == nt - 2);
            const char* a1 = cA + (size_t)(t + 1) * kstep;
            const char* a2 = last ? nA : cA + (size_t)(t + 2) * kstep; const char* b2 = last ? nB : cB + (size_t)(t + 2) * kstep;
            const char* a3 = a2 + kstep; const char* b3 = b2 + kstep;
            if (last && has_next) S.a_ready(nxt);
            if constexpr (SP2) {
            PG8_LDB(B0, 0, 0); PG8_LDB(B1, 0, 1); PG8_SCHED; PG8_LDA(At, 0, 0); PG8_STAGE(PG8_SA(1, 1), a1 + hstep, voffA);
            PG8_WAIT_V(8); PG8_WAIT_L(0); PG8_BAR; PG8_MMA(0, 0, At, B0); PG8_MMA(0, 1, At, B1); PG8_BAR; PG8_SCHED;
            PG8_LDA(At, 0, 1); PG8_STAGE(PG8_SB(0, 0), b2, voffB); PG8_STAGE(PG8_SB(0, 1), b2 + hstep, voffB); PG8_STAGE(PG8_SA(0, 0), a2, voffA);
            PG8_WAIT_V(8); PG8_WAIT_L(0); PG8_BAR; PG8_MMA(1, 0, At, B0); PG8_MMA(1, 1, At, B1); PG8_BAR; PG8_SCHED;
            PG8_LDB(B0, 1, 0); PG8_LDB(B1, 1, 1); PG8_SCHED; PG8_LDA(At, 1, 0); PG8_STAGE(PG8_SA(0, 1), a2 + hstep, voffA);
            PG8_WAIT_V(8); PG8_WAIT_L(0); PG8_BAR; PG8_MMA(0, 0, At, B0); PG8_MMA(0, 1, At, B1); PG8_BAR; PG8_SCHED;
            PG8_LDA(At, 1, 1); PG8_STAGE(PG8_SB(1, 0), b3, voffB); PG8_STAGE(PG8_SB(1, 1), b3 + hstep, voffB); PG8_STAGE(PG8_SA(1, 0), a3, voffA);
            PG8_WAIT_V(8); PG8_WAIT_L(0); PG8_BAR; PG8_MMA(1, 0, At, B0); PG8_MMA(1, 1, At, B1); PG8_BAR; PG8_SCHED;
            } else {
            PG8_LDB(B0, 0, 0); PG8_SCHED; PG8_LDA(At, 0, 0); PG8_STAGE(PG8_SA(1, 1), a1 + hstep, voffA);
            PG8_WAIT_L(8); PG8_BAR; PG8_WAIT_L(0); PG8_MMA(0, 0, At, B0); PG8_BAR; PG8_SCHED;
            PG8_LDB(B1, 0, 1); PG8_STAGE(PG8_SB(0, 0), b2, voffB);
            PG8_BAR; PG8_WAIT_L(0); PG8_MMA(0, 1, At, B1); PG8_BAR;
            PG8_LDA(At, 0, 1); PG8_STAGE(PG8_SA(0, 0), a2, voffA);
            PG8_BAR; PG8_WAIT_L(0); PG8_MMA(1, 0, At, B0); PG8_BAR; PG8_SCHED;
            PG8_STAGE(PG8_SB(0, 1), b2 + hstep, voffB);
            PG8_WAIT_V(6); PG8_BAR; PG8_MMA(1, 1, At, B1); PG8_BAR;
            PG8_LDB(B0, 1, 0); PG8_SCHED; PG8_LDA(At, 1, 0); PG8_STAGE(PG8_SA(0, 1), a2 + hstep, voffA);
            PG8_WAIT_L(8); PG8_BAR; PG8_WAIT_L(0); PG8_MMA(0, 0, At, B0); PG8_BAR; PG8_SCHED;
            PG8_LDB(B1, 1, 1); PG8_STAGE(PG8_SB(1, 0), b3, voffB);
            PG8_BAR; PG8_WAIT_L(0); PG8_MMA(0, 1, At, B1); PG8_BAR;
            PG8_LDA(At, 1, 1); PG8_STAGE(PG8_SA(1, 0), a3, voffA);
            PG8_BAR; PG8_WAIT_L(0); PG8_MMA(1, 0, At, B0); PG8_BAR; PG8_SCHED;
            PG8_STAGE(PG8_SB(1, 1), b3 + hstep, voffB);
            PG8_WAIT_V(6); PG8_BAR; PG8_MMA(1, 1, At, B1); PG8_BAR;
            }
        }
        if constexpr (ALIGN_EPI) { if (wr == 0) PG8_BAR; }
        if constexpr (!Epi::AFTER_DRAIN) { E(acc, cur, wr, wc, fr, fq); S.done(cur); }
        if (!has_next) break;
#pragma unroll
        for (int a = 0; a < 2; ++a)
#pragma unroll
            for (int b = 0; b < 2; ++b)
#pragma unroll
                for (int m = 0; m < 4; ++m)
#pragma unroll
                    for (int n = 0; n < 2; ++n) acc[a][b][m][n] = (f32x4){0.f, 0.f, 0.f, 0.f};
        cur = nxt; cA = nA; cB = nB; ++ui;
        if constexpr (ALIGN_EPI) { if (wr == 1) PG8_BAR; }
    }
    PG8_WAIT_V(0);
    if constexpr (!ALIGN_EPI) { if (wr == 0) PG8_BAR; }
    PG8_BAR;
    if constexpr (Epi::AFTER_DRAIN) { E.fused(acc, cur, wr, wc, fr, fq, lds, wid, lane); S.done(cur); }
#undef PG8_SA
#undef PG8_SB
#undef PG8_STAGE
#undef PG8_LDA
#undef PG8_LDB
#undef PG8_MMA
#undef PG8_WAIT_V
#undef PG8_WAIT_L
#undef PG8_BAR
#undef PG8_SCHED
}
}
namespace att {
#define LAS __attribute__((address_space(3)))
typedef unsigned short bf16_t;
typedef short bf16x8 __attribute__((ext_vector_type(8)));
typedef short s16x4 __attribute__((ext_vector_type(4)));
typedef short v4i16_t __attribute__((ext_vector_type(4)));
typedef float f32x4 __attribute__((ext_vector_type(4)));
typedef float f32x16 __attribute__((ext_vector_type(16)));
typedef unsigned u32x4 __attribute__((ext_vector_type(4)));
constexpr int KOFF = 0, VOFF = 16384, CUM_OFF = 32768, WSF_OFF = 49152, PF_OFF = 51200;
constexpr float LOG2E = 1.4426950408889634f;
__device__ __forceinline__ int crow(int r, int hi) { return (r & 3) + 8 * (r >> 2) + 4 * hi; }
__device__ __forceinline__ unsigned cvtpk(float lo, float hi) { unsigned r; asm volatile("v_cvt_pk_bf16_f32 %0, %1, %2" : "=v"(r) : "v"(lo), "v"(hi)); return r; }
__device__ __forceinline__ s16x4 vtr(const LAS unsigned char* p) { return __builtin_bit_cast(s16x4, __builtin_amdgcn_ds_read_tr16_b64_v4i16((LAS v4i16_t*)p)); }

struct Unit {
    const bf16_t* Q; const bf16_t* K; const bf16_t* V; bf16_t* O;
    long stride;
    int q0, t_lo, t_hi, window;
    int bias;
    int dry;
    float* lse; long lse_stride;
};

__device__ __forceinline__ void unit_run(LAS unsigned char* lds, const Unit& U) {
    int tid_ = threadIdx.x; asm volatile("" : "+v"(tid_)); const int tid = tid_, lane = tid & 63, r32 = lane & 31, hi = lane >> 5;
    const int wid = __builtin_amdgcn_readfirstlane(tid >> 6);
    const int srow = tid >> 3, sch = tid & 7;
    const bf16_t* kg = U.K + (long)srow * U.stride + sch * 8;
    const bf16_t* vg = U.V + (long)srow * U.stride + sch * 8;
    const int kst = KOFF + sch * 1024 + srow * 16;
    const int vst = VOFF + (sch >> 2) * 4096 + srow * 64 + (sch & 3) * 16;
    const int uq = U.q0 + wid * 32 + r32;
    bf16x8 qr[4];
#pragma unroll
    for (int d0 = 0; d0 < 4; ++d0) qr[d0] = *(const bf16x8*)(U.Q + (long)uq * U.stride + d0 * 16 + hi * 8);
    float m = -1e30f, l = 0.f;
    f32x16 o0, o1;
#pragma unroll
    for (int r = 0; r < 16; ++r) { o0[r] = 0.f; o1[r] = 0.f; }
    LAS float* wsf = (LAS float*)(lds + WSF_OFF) + wid * 64;
    const LAS float* cumL = (const LAS float*)(lds + CUM_OFF);
    const int wq_lo = U.q0 + wid * 32, wq_hi = wq_lo + 31;
    u32x4 kreg, vreg;
    {
        const long go = (long)U.t_lo * 64 * U.stride;
        kreg = *(const u32x4*)(kg + go); vreg = *(const u32x4*)(vg + go);
        *(LAS u32x4*)(lds + kst) = kreg; *(LAS u32x4*)(lds + vst) = vreg;
        if (U.t_lo + 1 < U.t_hi) { const long g1 = go + 64 * U.stride; kreg = *(const u32x4*)(kg + g1); vreg = *(const u32x4*)(vg + g1); }
    }
    const LAS unsigned char* vp0 = lds + VOFF + ((lane >> 4) & 1) * 32 + (lane & 3) * 8 + (4 * hi + ((lane & 15) >> 2)) * 64;
    const LAS unsigned char* kp0 = lds + KOFF + hi * 1024 + r32 * 16;
    for (int t = U.t_lo; t < U.t_hi; ++t) {
        const int cur = (t - U.t_lo) & 1;
        __syncthreads();
        if (t + 1 < U.t_hi) { *(LAS u32x4*)(lds + kst + (cur ^ 1) * 8192) = kreg; *(LAS u32x4*)(lds + vst + (cur ^ 1) * 8192) = vreg; }
        if (t + 2 < U.t_hi) { const long go = (long)(t + 2) * 64 * U.stride; kreg = *(const u32x4*)(kg + go); vreg = *(const u32x4*)(vg + go); }
        const bool need = (64 * t <= wq_hi) && (64 * t + 63 >= wq_lo - U.window);
        if (need) {
            const LAS unsigned char* kb = kp0 + cur * 8192;
            f32x16 p0, p1;
#pragma unroll
            for (int r = 0; r < 16; ++r) { p0[r] = 0.f; p1[r] = 0.f; }
#pragma unroll
            for (int d0 = 0; d0 < 4; ++d0) {
                const bf16x8 b0 = *(const LAS bf16x8*)(kb + d0 * 2048), b1 = *(const LAS bf16x8*)(kb + d0 * 2048 + 512);
                p0 = __builtin_amdgcn_mfma_f32_32x32x16_bf16(b0, qr[d0], p0, 0, 0, 0);
                p1 = __builtin_amdgcn_mfma_f32_32x32x16_bf16(b1, qr[d0], p1, 0, 0, 0);
            }
            if (U.bias) {
#pragma unroll
                for (int g = 0; g < 4; ++g) {
                    const f32x4 c0 = *(const LAS f32x4*)(cumL + 64 * t + 8 * g + 4 * hi), c1 = *(const LAS f32x4*)(cumL + 64 * t + 32 + 8 * g + 4 * hi);
#pragma unroll
                    for (int e = 0; e < 4; ++e) { p0[4 * g + e] += c0[e]; p1[4 * g + e] += c1[e]; }
                }
            }
            const bool need_mask = (64 * t + 63 > wq_lo) || (64 * t < wq_hi - U.window);
            if (need_mask) {
                const int lo_ok = uq - U.window;
#pragma unroll
                for (int r = 0; r < 16; ++r) {
                    const int kv = 64 * t + crow(r, hi);
                    if (kv > uq || kv < lo_ok) p0[r] = -INFINITY;
                    if (kv + 32 > uq || kv + 32 < lo_ok) p1[r] = -INFINITY;
                }
            }
            float mx = fmaxf(p0[0], p1[0]);
#pragma unroll
            for (int r = 1; r < 16; ++r) mx = fmaxf(mx, fmaxf(p0[r], p1[r]));
            mx = fmaxf(mx, __shfl_xor(mx, 32));
            const float mn = fmaxf(m, mx);
            const float alpha = __builtin_amdgcn_exp2f(m - mn);
            m = mn;
            float rs = 0.f;
#pragma unroll
            for (int r = 0; r < 16; ++r) { p0[r] = __builtin_amdgcn_exp2f(p0[r] - mn); p1[r] = __builtin_amdgcn_exp2f(p1[r] - mn); rs += p0[r] + p1[r]; }
            l = l * alpha + rs;
            if (hi == 0) wsf[r32] = alpha;
#pragma unroll
            for (int g = 0; g < 4; ++g) {
                const f32x4 a = *(const LAS f32x4*)(wsf + 8 * g + 4 * hi);
#pragma unroll
                for (int e = 0; e < 4; ++e) { o0[4 * g + e] *= a[e]; o1[4 * g + e] *= a[e]; }
            }
            u32x4 pw[4];
#pragma unroll
            for (int c = 0; c < 4; ++c) {
                pw[0][c] = cvtpk(p0[2 * c], p0[2 * c + 1]); pw[1][c] = cvtpk(p0[8 + 2 * c], p0[8 + 2 * c + 1]);
                pw[2][c] = cvtpk(p1[2 * c], p1[2 * c + 1]); pw[3][c] = cvtpk(p1[8 + 2 * c], p1[8 + 2 * c + 1]);
            }
            const LAS unsigned char* vp = vp0 + cur * 8192;
#pragma unroll
            for (int ks = 0; ks < 4; ++ks) {
                const s16x4 a0 = vtr(vp + ks * 1024), a1 = vtr(vp + ks * 1024 + 512), c0 = vtr(vp + 4096 + ks * 1024), c1 = vtr(vp + 4096 + ks * 1024 + 512);
                const bf16x8 pa = __builtin_bit_cast(bf16x8, pw[ks]);
                const bf16x8 v0 = (bf16x8){a0[0], a0[1], a0[2], a0[3], a1[0], a1[1], a1[2], a1[3]};
                const bf16x8 v1 = (bf16x8){c0[0], c0[1], c0[2], c0[3], c1[0], c1[1], c1[2], c1[3]};
                o0 = __builtin_amdgcn_mfma_f32_32x32x16_bf16(pa, v0, o0, 0, 0, 0);
                o1 = __builtin_amdgcn_mfma_f32_32x32x16_bf16(pa, v1, o1, 0, 0, 0);
            }
        }
    }
    l += __shfl_xor(l, 32);
    if (hi == 0) { wsf[32 + r32] = l; if (U.lse && !U.dry) U.lse[(long)uq * U.lse_stride] = m + __builtin_amdgcn_logf(l); }
    if (U.dry) return;
    bf16_t* Ow = U.O + (long)(U.q0 + wid * 32) * U.stride;
#pragma unroll
    for (int g = 0; g < 4; ++g) {
        const f32x4 lv = *(const LAS f32x4*)(wsf + 32 + 8 * g + 4 * hi);
#pragma unroll
        for (int e = 0; e < 4; ++e) {
            const int r = 4 * g + e; const float rl = 1.0f / lv[e];
            bf16_t* op = Ow + (long)crow(r, hi) * U.stride + r32;
            const unsigned w0 = cvtpk(o0[r] * rl, 0.f), w1 = cvtpk(o1[r] * rl, 0.f);
            op[0] = (bf16_t)(w0 & 0xffffu); op[32] = (bf16_t)(w1 & 0xffffu);
        }
    }
}
#undef LAS
}
namespace fatt {
using bf16=__hip_bfloat16;
using bf16x8=__attribute__((ext_vector_type(8)))short;
using s16x4=__attribute__((ext_vector_type(4)))short;
using f32x16=__attribute__((ext_vector_type(16)))float;
using u32x4=__attribute__((ext_vector_type(4)))unsigned;
constexpr int BATCH=8,NHEAD=16,SEQ=4096,D=64,DM=NHEAD*D;
constexpr int NW=8,QBLK=32,QB=QBLK*NW,KVBLK=64,NQB=SEQ/QB;
constexpr int ATTN_PITCH=DM, ATTN_UNIT_ROWS=QB;
__device__ __forceinline__ int crow(int r,int hi){return (r&3)+8*(r>>2)+4*hi;}
#define SBAR() __builtin_amdgcn_sched_barrier(0)
__device__ __forceinline__ void cmask(f32x16&p0,f32x16&p1,int jb,int qrel,int hi){
  const float NEG=-INFINITY; int kb=64*jb+4*hi;
  #pragma unroll
  for(int r=0;r<16;++r){int kv=kb+(r&3)+8*(r>>2); if(kv>qrel)p0[r]=NEG; if(kv+32>qrel)p1[r]=NEG;}
}

constexpr int NSLOT=3, SLOTB=8192;
constexpr int LDS_K=0, LDS_V=NSLOT*SLOTB, LDS_WS=2*NSLOT*SLOTB, LDS_OST=LDS_WS+NW*64*4, LDS_BYTES=LDS_OST+NW*4096;
constexpr int D_OFF=LDS_BYTES, CT_OFF=D_OFF+16384+256, PFX_OFF=CT_OFF+512, WT_OFF=PFX_OFF+1024, FOX_LDS_BYTES=WT_OFF+64;
constexpr float C2=0.125f*1.4426950408889634f;
__device__ __forceinline__ void glds16(const void*gsrc,unsigned lds_dst){unsigned keep;
  asm volatile("s_mov_b32 %0, m0\n\ts_mov_b32 m0, %2\n\ts_nop 0\n\tglobal_load_lds_dwordx4 %1, off\n\ts_mov_b32 m0, %0":"=&s"(keep):"v"(gsrc),"s"(lds_dst):"memory");}
__device__ __forceinline__ float max3f(float a,float b,float c){float r;asm("v_max3_f32 %0, %1, %2, %3":"=v"(r):"v"(a),"v"(b),"v"(c));return r;}
__device__ __forceinline__ float max2f(float a,float b){float r;asm("v_max_f32_e32 %0, %1, %2":"=v"(r):"v"(a),"v"(b));return r;}
__device__ __forceinline__ float fadd_s(float a,float b){float r;asm("v_add_f32_e32 %0, %1, %2":"=v"(r):"v"(a),"v"(b));return r;}
__device__ __forceinline__ float fsub_s(float a,float b){float r;asm("v_sub_f32_e32 %0, %1, %2":"=v"(r):"v"(a),"v"(b));return r;}
typedef float f32x2_t __attribute__((ext_vector_type(2))); typedef __bf16 bf16x2_t __attribute__((ext_vector_type(2)));
__device__ __forceinline__ unsigned cvtpk_s(float lo,float hi){f32x2_t v={lo,hi};bf16x2_t b=__builtin_convertvector(v,bf16x2_t);return __builtin_bit_cast(unsigned,b);}
#define WAIT_BAR(N) asm volatile("s_waitcnt vmcnt(" #N ") lgkmcnt(0)\n\ts_barrier":::"memory")

__device__ __forceinline__ void qkt(f32x16&p0,f32x16&p1,const char*Kslot,const bf16x8*qr,const f32x16&negm,int r32,int hi){
  const char*kb=Kslot+hi*1024+r32*16;
  #pragma unroll
  for(int d0=0;d0<4;++d0){
    const bf16x8 b0=*reinterpret_cast<const bf16x8*>(kb+d0*2048);
    const bf16x8 b1=*reinterpret_cast<const bf16x8*>(kb+d0*2048+512);
    if(d0==0){p0=__builtin_amdgcn_mfma_f32_32x32x16_bf16(b0,qr[0],negm,0,0,0);p1=__builtin_amdgcn_mfma_f32_32x32x16_bf16(b1,qr[0],negm,0,0,0);}
    else{p0=__builtin_amdgcn_mfma_f32_32x32x16_bf16(b0,qr[d0],p0,0,0,0);p1=__builtin_amdgcn_mfma_f32_32x32x16_bf16(b1,qr[d0],p1,0,0,0);}}
}
typedef __attribute__((address_space(3))) const char* lds_cptr;
typedef short v4i16_t __attribute__((ext_vector_type(4)));
typedef float f32x4v __attribute__((ext_vector_type(4)));
__device__ __forceinline__ void kload8(bf16x8*kf,lds_cptr kp){
  kf[0]=*(const __attribute__((address_space(3))) bf16x8*)(kp);      kf[1]=*(const __attribute__((address_space(3))) bf16x8*)(kp+512);
  kf[2]=*(const __attribute__((address_space(3))) bf16x8*)(kp+2048); kf[3]=*(const __attribute__((address_space(3))) bf16x8*)(kp+2560);
  kf[4]=*(const __attribute__((address_space(3))) bf16x8*)(kp+4096); kf[5]=*(const __attribute__((address_space(3))) bf16x8*)(kp+4608);
  kf[6]=*(const __attribute__((address_space(3))) bf16x8*)(kp+6144); kf[7]=*(const __attribute__((address_space(3))) bf16x8*)(kp+6656);
}
__device__ __forceinline__ void kload2(bf16x8*kf,lds_cptr kp,int j){ kf[2*j]=*(const __attribute__((address_space(3))) bf16x8*)(kp+j*2048); kf[2*j+1]=*(const __attribute__((address_space(3))) bf16x8*)(kp+j*2048+512); }
__device__ __forceinline__ s16x4 vtr(lds_cptr p){ return __builtin_bit_cast(s16x4,__builtin_amdgcn_ds_read_tr16_b64_v4i16((__attribute__((address_space(3))) v4i16_t*)p)); }
__device__ __forceinline__ float rowmax(const f32x16&p0,const f32x16&p1){
  float a=max3f(p0[0],p0[1],p1[0]),b=max3f(p0[2],p0[3],p1[1]);a=max3f(a,p1[2],p1[3]);
  #pragma unroll
  for(int r=4;r<16;r+=4){a=max3f(a,p0[r],p0[r+1]);b=max3f(b,p0[r+2],p0[r+3]);a=max3f(a,p1[r],p1[r+1]);b=max3f(b,p1[r+2],p1[r+3]);}
  const float m=max2f(a,b);
  auto rr=__builtin_amdgcn_permlane32_swap(__float_as_uint(m),__float_as_uint(m),false,false);
  return max2f(__uint_as_float(rr[0]),__uint_as_float(rr[1]));
}
__device__ __forceinline__ void pv(f32x16*o,int vb,bf16x8 pa0,bf16x8 pa1,bf16x8 pa2,bf16x8 pa3){
  #pragma unroll
  for(int d0=0;d0<2;++d0){s16x4 lo[4],hi[4];
    #pragma unroll
    for(int ks=0;ks<4;++ks){
      asm volatile("ds_read_b64_tr_b16 %0,%1 offset:%c2":"=&v"(lo[ks]):"v"(vb),"i"(d0*4096+ks*1024):"memory");
      asm volatile("ds_read_b64_tr_b16 %0,%1 offset:%c2":"=&v"(hi[ks]):"v"(vb),"i"(d0*4096+ks*1024+512):"memory");}
    asm volatile("s_waitcnt lgkmcnt(0)":::"memory");SBAR();
    #define PK(k) (bf16x8){lo[k][0],lo[k][1],lo[k][2],lo[k][3],hi[k][0],hi[k][1],hi[k][2],hi[k][3]}
    o[d0]=__builtin_amdgcn_mfma_f32_32x32x16_bf16(pa0,PK(0),o[d0],0,0,0);
    o[d0]=__builtin_amdgcn_mfma_f32_32x32x16_bf16(pa1,PK(1),o[d0],0,0,0);
    o[d0]=__builtin_amdgcn_mfma_f32_32x32x16_bf16(pa2,PK(2),o[d0],0,0,0);
    o[d0]=__builtin_amdgcn_mfma_f32_32x32x16_bf16(pa3,PK(3),o[d0],0,0,0);
    #undef PK
  }
}

#ifndef ATTN_STORE16
#define ATTN_STORE16(p,v) (*(u32x4*)(p)=(v))
#endif
template<int THRL> __device__ __forceinline__ void attn_unit(int b,int h,int qb,const bf16*Q,const bf16*__restrict__ K,const bf16*__restrict__ V,bf16*O,char*shm,int dry=0){
  int tid_=threadIdx.x; asm volatile("":"+v"(tid_)); const int tid=tid_,lane=tid&63,r32=lane&31,hi=lane>>5; const int wid=__builtin_amdgcn_readfirstlane(tid>>6);
  const long rowbase=(long)b*SEQ; const int q0=qb*QB;
  const bf16*Qw=Q+(rowbase+q0+wid*QBLK)*DM+h*D;
  const bf16*Kh=K+rowbase*DM+h*D,*Vh=V+rowbase*DM+h*D;
  const unsigned lds0=(unsigned)(uintptr_t)shm;
  float*wsf=(float*)(shm+LDS_WS)+wid*64;
  const bf16*ksrc=Kh+(long)lane*DM+wid*8;
  const bf16*vsrc=Vh+(long)(16*(wid&3)+(lane>>2))*DM+(wid>>2)*32+(lane&3)*8;
  const unsigned kdst=lds0+LDS_K+wid*1024, vdst=lds0+LDS_V+wid*1024;
  #define DMA_K(t,slot) glds16(ksrc+(long)(t)*KVBLK*DM,(unsigned)__builtin_amdgcn_readfirstlane(kdst+(slot)))
  #define DMA_V(t,slot) glds16(vsrc+(long)(t)*KVBLK*DM,(unsigned)__builtin_amdgcn_readfirstlane(vdst+(slot)))
  const int vb0=(int)(lds0+LDS_V)+((lane>>4)&1)*32+(lane&3)*8+(4*hi+((lane&15)>>2))*64;
  const char*Kbase=shm+LDS_K; bf16x8 kf[8];
  typedef __attribute__((address_space(3))) const float* lds_fptr; typedef __attribute__((address_space(3))) const f32x4v* lds_f4ptr;
  const lds_cptr shm3=(lds_cptr)shm; const lds_fptr dLh=(lds_fptr)(shm3+D_OFF)+4*hi; const lds_fptr ctL=(lds_fptr)(shm3+CT_OFF); const lds_cptr kp0=shm3+LDS_K+hi*1024+r32*16; const lds_cptr vp0=shm3+LDS_V+((lane>>4)&1)*32+(lane&3)*8+(4*hi+((lane&15)>>2))*64;
  const int NT=(q0+QB)/KVBLK;
  DMA_K(0,0);DMA_V(0,0);DMA_K(1,SLOTB);
  bf16x8 qr[4];
  #pragma unroll
  for(int d0=0;d0<4;++d0)qr[d0]=*reinterpret_cast<const bf16x8*>(&Qw[(long)r32*DM+d0*16+hi*8]);
  float mhat=0.f,l_reg=0.f;f32x16 o[2];o[0]=f32x16{};o[1]=f32x16{};float cmv=ctL[0]; float ctn=ctL[1];
  #define DLD(t,j) (*(lds_f4ptr)(dLh+64*(t)+8*(j)))
  const int qrel=wid*QBLK+r32;
  #define CMASK(P0,P1,t) do{int jb_=(t)-(NT-4); if(jb_>=0)cmask(P0,P1,jb_,qrel,hi);}while(0)
  bool resc=false;
  #define START(P0,P1) do{ const float rm=fadd_s(rowmax(P0,P1),cmv); resc=false; mhat=fadd_s(mhat,rm); cmv=fsub_s(cmv,rm); \
    _Pragma("unroll") for(int j_=0;j_<4;++j_){ const f32x4v dv_=DLD(0,j_); _Pragma("unroll") for(int e_=0;e_<4;++e_)P0[4*j_+e_]=__builtin_amdgcn_exp2f(P0[4*j_+e_]+(dv_[e_]+cmv)); } }while(0)
  #define RESC() do{ if(resc){ asm volatile("s_waitcnt lgkmcnt(0)":::"memory"); \
      _Pragma("unroll") for(int d_=0;d_<2;++d_) _Pragma("unroll") for(int r=0;r<16;++r)o[d_][r]*=wsf[crow(r,hi)]; } }while(0)
  f32x16 pA0,pA1,pB0,pB1;
  int sl_prev=0,sl_cur=0,sl_next=SLOTB;
  #define ROT() do{sl_prev=sl_cur;sl_cur=sl_next;sl_next=(sl_next==(NSLOT-1)*SLOTB)?0:sl_next+SLOTB;}while(0)
  DMA_K(2,2*SLOTB);
  WAIT_BAR(3);
  qkt(pA0,pA1,Kbase,qr,f32x16{},r32,hi);asm volatile("s_nop 15\n\ts_nop 7":"+v"(pA0),"+v"(pA1));CMASK(pA0,pA1,0);
  START(pA0,pA1);
  _Pragma("unroll") for(int j_=0;j_<4;++j_){ const f32x4v dv_=DLD(0,4+j_); _Pragma("unroll") for(int e_=0;e_<4;++e_)pA1[4*j_+e_]=__builtin_amdgcn_exp2f(pA1[4*j_+e_]+(dv_[e_]+cmv)); }
  WAIT_BAR(0);
  DMA_K(3,0);DMA_V(1,SLOTB);
  ROT();
  kload8(kf,kp0+sl_cur);
  WAIT_BAR(2);
  s16x4 vlo[8],vhi[8]; u32x4 pw0,pw1,pw2,pw3;
  #define PKW(P,B) cvtpk_s(P[B],P[B+1])
  #define PAF(k) __builtin_bit_cast(bf16x8,pw##k)
  #define VFR(i) (bf16x8){vlo[i][0],vlo[i][1],vlo[i][2],vlo[i][3],vhi[i][0],vhi[i][1],vhi[i][2],vhi[i][3]}
  #define PIN(x) asm volatile("":"+v"(x))
  #define MX3(a,b,c) __builtin_fmaxf(__builtin_fmaxf((a),(b)),(c))
  #define GAPA(MF,A0,A1,A2,A3,W0,W1,PW) do{ MF; sacc+=A0; sacc+=A1; sacc+=A2; sacc+=A3; PIN(sacc); W0; W1; PIN(PW); SBAR(); }while(0)
  #define EX(v) __builtin_amdgcn_exp2f(v)
  #define GAPB(MF,X,B,DC,DN,JN) do{ MF; dA_=dA_+cmv; X[B]=EX(X[B]+dA_[0]); X[B+1]=EX(X[B+1]+dA_[1]); X[B+2]=EX(X[B+2]+dA_[2]); X[B+3]=EX(X[B+3]+dA_[3]); dA_=dp_[2*(JN)]; PIN(X); SBAR(); }while(0)
  #define VRD(i) do{ vlo[i]=vtr(vp_+(((i)>>2)*4096+((i)&3)*1024)); vhi[i]=vtr(vp_+(((i)>>2)*4096+((i)&3)*1024+512)); }while(0)
  #define KRD(G,j) do{ if(G){ kload2(kf,kp0+sl_next,j); SBAR(); } }while(0)
  #define STEP(C0,C1,P0,P1,t,GK,GV,GL) do{ SBAR(); \
    cmv=fsub_s(ctn,mhat); ctn=ctL[(t)+1]; \
    const lds_f4ptr dp_=(lds_f4ptr)(dLh+64*(t)); f32x4v dA_; \
    const lds_cptr vp_=vp0+sl_prev; \
    VRD(0); SBAR(); float sacc=(P0[0]+P0[1]); \
    GAPA(C0=__builtin_amdgcn_mfma_f32_32x32x16_bf16(kf[0],qr[0],f32x16{},0,0,0), P0[2],P0[3],P0[4],P0[5],     pw0[0]=PKW(P0,0), pw0[1]=PKW(P0,2), pw0); \
    VRD(4); SBAR(); GAPA(C1=__builtin_amdgcn_mfma_f32_32x32x16_bf16(kf[1],qr[0],f32x16{},0,0,0), P0[6],P0[7],P0[8],P0[9],     pw0[2]=PKW(P0,4), pw0[3]=PKW(P0,6), pw0); \
    VRD(1); SBAR(); GAPA(C0=__builtin_amdgcn_mfma_f32_32x32x16_bf16(kf[2],qr[1],C0,0,0,0),   P0[10],P0[11],P0[12],P0[13], pw1[0]=PKW(P0,8), pw1[1]=PKW(P0,10), pw1); \
    VRD(5); SBAR(); GAPA(C1=__builtin_amdgcn_mfma_f32_32x32x16_bf16(kf[3],qr[1],C1,0,0,0),   P0[14],P0[15],P1[0],P1[1],   pw1[2]=PKW(P0,12),pw1[3]=PKW(P0,14), pw1); \
    VRD(2); SBAR(); GAPA(C0=__builtin_amdgcn_mfma_f32_32x32x16_bf16(kf[4],qr[2],C0,0,0,0),   P1[2],P1[3],P1[4],P1[5],     pw2[0]=PKW(P1,0), pw2[1]=PKW(P1,2), pw2); \
    VRD(6); SBAR(); GAPA(C1=__builtin_amdgcn_mfma_f32_32x32x16_bf16(kf[5],qr[2],C1,0,0,0),   P1[6],P1[7],P1[8],P1[9],     pw2[2]=PKW(P1,4), pw2[3]=PKW(P1,6), pw2); \
    VRD(3); SBAR(); GAPA(C0=__builtin_amdgcn_mfma_f32_32x32x16_bf16(kf[6],qr[3],C0,0,0,0),   P1[10],P1[11],P1[12],P1[13], pw3[0]=PKW(P1,8), pw3[1]=PKW(P1,10), pw3); \
    VRD(7); SBAR(); GAPA(C1=__builtin_amdgcn_mfma_f32_32x32x16_bf16(kf[7],qr[3],C1,0,0,0),   P1[14],P1[15],0.f,0.f,       pw3[2]=PKW(P1,12),pw3[3]=PKW(P1,14), pw3); \
    l_reg+=sacc; \
    if(GK){DMA_K((t)+3,sl_cur);} if(GV){DMA_V((t)+1,sl_next);} dA_=dp_[0]; \
    CMASK(C0,C1,t); \
    { float a=MX3(C0[0],C0[1],C1[0]),b=MX3(C0[2],C0[3],C1[1]); a=MX3(a,C1[2],C1[3]); \
      _Pragma("unroll") for(int r=4;r<16;r+=4){a=MX3(a,C0[r],C0[r+1]);b=MX3(b,C0[r+2],C0[r+3]);a=MX3(a,C1[r],C1[r+1]);b=MX3(b,C1[r+2],C1[r+3]);} \
      float rm=__builtin_fmaxf(a,b); { auto rr=__builtin_amdgcn_permlane32_swap(__float_as_uint(rm),__float_as_uint(rm),false,false); rm=__builtin_fmaxf(__uint_as_float(rr[0]),__uint_as_float(rr[1])); } \
      rm+=cmv; resc=false; \
      if(__builtin_expect(__any(rm>(float)THRL),0)){ const float dl=__builtin_fmaxf(rm,0.f); mhat+=dl; cmv-=dl; \
        const float f=__builtin_amdgcn_exp2f(-dl); l_reg*=f; if(hi==0)wsf[r32]=f; resc=true; } } \
    SBAR(); \
    GAPB(o[0]=__builtin_amdgcn_mfma_f32_32x32x16_bf16(PAF(0),VFR(0),o[0],0,0,0), C0,0,dA_,dB_,1); \
    GAPB(o[1]=__builtin_amdgcn_mfma_f32_32x32x16_bf16(PAF(0),VFR(4),o[1],0,0,0), C0,4,dB_,dA_,2); \
    KRD(GL,0); GAPB(o[0]=__builtin_amdgcn_mfma_f32_32x32x16_bf16(PAF(1),VFR(1),o[0],0,0,0), C0,8,dA_,dB_,3); \
    KRD(GL,1); GAPB(o[1]=__builtin_amdgcn_mfma_f32_32x32x16_bf16(PAF(1),VFR(5),o[1],0,0,0), C0,12,dB_,dA_,4); \
    KRD(GL,2); GAPB(o[0]=__builtin_amdgcn_mfma_f32_32x32x16_bf16(PAF(2),VFR(2),o[0],0,0,0), C1,0,dA_,dB_,5); \
    KRD(GL,3); GAPB(o[1]=__builtin_amdgcn_mfma_f32_32x32x16_bf16(PAF(2),VFR(6),o[1],0,0,0), C1,4,dB_,dA_,6); \
    GAPB(o[0]=__builtin_amdgcn_mfma_f32_32x32x16_bf16(PAF(3),VFR(3),o[0],0,0,0), C1,8,dA_,dB_,7); \
    GAPB(o[1]=__builtin_amdgcn_mfma_f32_32x32x16_bf16(PAF(3),VFR(7),o[1],0,0,0), C1,12,dB_,dA_,7); \
    }while(0)
  int t=1;
  #undef CMASK
  #define CMASK(P0,P1,t) do{}while(0)
  for(;t+5<NT;t+=2){
    STEP(pB0,pB1,pA0,pA1,t,true,true,true);     WAIT_BAR(2); RESC(); ROT();
    STEP(pA0,pA1,pB0,pB1,t+1,true,true,true);   WAIT_BAR(2); RESC(); ROT();
  }
  #undef CMASK
  #define CMASK(P0,P1,t) do{int jb_=(t)-(NT-4); if(jb_>=0)cmask(P0,P1,jb_,qrel,hi);}while(0)
  #define ENDW(tt) do{ if((tt)+3<NT){WAIT_BAR(2);} else if((tt)+2<NT){WAIT_BAR(1);} else {WAIT_BAR(0);} }while(0)
  for(;t+1<NT;t+=2){
    STEP(pB0,pB1,pA0,pA1,t,(t+3<NT),(t+1<NT),(t+1<NT));       ENDW(t);   RESC(); ROT();
    STEP(pA0,pA1,pB0,pB1,t+1,(t+4<NT),(t+2<NT),(t+2<NT));     ENDW(t+1); RESC(); ROT();
  }
  STEP(pB0,pB1,pA0,pA1,NT-1,false,false,false); RESC();
  { float sacc=pB0[0]+pB0[1]; _Pragma("unroll") for(int r=2;r<16;++r)sacc+=pB0[r]; _Pragma("unroll") for(int r=0;r<16;++r)sacc+=pB1[r]; l_reg+=sacc;
    pw0=(u32x4){PKW(pB0,0),PKW(pB0,2),PKW(pB0,4),PKW(pB0,6)};pw1=(u32x4){PKW(pB0,8),PKW(pB0,10),PKW(pB0,12),PKW(pB0,14)};pw2=(u32x4){PKW(pB1,0),PKW(pB1,2),PKW(pB1,4),PKW(pB1,6)};pw3=(u32x4){PKW(pB1,8),PKW(pB1,10),PKW(pB1,12),PKW(pB1,14)};
    SBAR(); pv(o,vb0+sl_cur,PAF(0),PAF(1),PAF(2),PAF(3)); }
  #undef PKW
  #undef PAF
  #undef VFR
  #undef PIN
  #undef MX3
  #undef GAPA
  #undef GAPB
  #undef EX
  #undef VRD
  #undef KRD
  #undef STEP
  #undef ENDW
  {auto rr=__builtin_amdgcn_permlane32_swap(__float_as_uint(l_reg),__float_as_uint(l_reg),false,false);l_reg=__uint_as_float(rr[0])+__uint_as_float(rr[1]);}
  if(hi==0)wsf[32+r32]=l_reg;asm volatile("s_waitcnt lgkmcnt(0)":::"memory");
  float rli[16];
  #pragma unroll
  for(int r=0;r<16;++r)rli[r]=__builtin_amdgcn_rcpf(wsf[32+crow(r,hi)]);
  bf16*Ow=O+(rowbase+q0+wid*QBLK)*DM+h*D;
  { bf16*stg=(bf16*)(shm+LDS_OST)+wid*2048;
    #pragma unroll
    for(int r=0;r<16;++r){const int orow=crow(r,hi);
      #pragma unroll
      for(int d0=0;d0<2;++d0)stg[orow*64+d0*32+r32]=__float2bfloat16(o[d0][r]*rli[r]);}
    asm volatile("s_waitcnt lgkmcnt(0)":::"memory");
    #pragma unroll
    for(int i=0;i<4;++i){const int row=i*8+(lane>>3),ch=lane&7; const u32x4 v=*(const u32x4*)(stg+row*64+ch*8); if(!dry)ATTN_STORE16(Ow+(long)row*DM+ch*8,v);} }
  asm volatile("s_waitcnt lgkmcnt(0)\n\ts_barrier":::"memory");
  #undef DMA_K
  #undef DLD
  #undef DMA_V
  #undef CMASK
  #undef START
  #undef RESC
  #undef ROT
}
constexpr int ATTN_LDS_BYTES=LDS_BYTES;
struct AttnTensors { const bf16* Q; const bf16* K; const bf16* V; bf16* O; };
struct AttnUnit { int bh; int qb; };
struct StaticOrder {
  int vcu;
  __device__ __forceinline__ explicit StaticOrder(int grid,int block):vcu((block%8)*(grid/8)+block/8){}
  __device__ __forceinline__ bool next(int i,AttnUnit&u)const{ if(i>=4)return false; const int s=vcu&7; u.bh=vcu>>3; u.qb=(i==0)?s:(i==1)?15-s:(i==2)?16+s:31-s; return true; }
  __device__ __forceinline__ void a_ready(const AttnUnit&)const{}
  __device__ __forceinline__ void done(const AttnUnit&)const{}
};
template<class Sched,int THRL=8> __device__ __forceinline__ void attn_phase(char*lds,const AttnTensors&T,const Sched&S){
  AttnUnit u;
  for(int i=0;S.next(i,u);++i){ S.a_ready(u); attn_unit<THRL>(u.bh/NHEAD,u.bh%NHEAD,u.qb,T.Q,T.K,T.V,T.O,lds); S.done(u); }
}
#undef SBAR
#undef WAIT_BAR
}
#define LAS __attribute__((address_space(3)))
typedef unsigned short bf16_t;
typedef float f32x4 __attribute__((ext_vector_type(4)));
typedef unsigned u32x4 __attribute__((ext_vector_type(4)));
typedef unsigned u32x2 __attribute__((ext_vector_type(2)));

constexpr int NB = 8, SEQ = 4096, DM = 1024, MT = NB * SEQ, FF = 2816, NH = 16, MODN = 9216;
constexpr int NTHREADS = 512, NWAVES = 8;
constexpr float LOG2E = 1.4426950408889634f;
constexpr size_t MiB = (size_t)1 << 20;
constexpr size_t WS_BAR = 0, WS_BAR_BYTES = 16384;
constexpr size_t WS_MOD = 1 * MiB, WS_COS = 3 * MiB, WS_SIN = 4 * MiB, WS_CUM = 5 * MiB, WS_CHT = 7 * MiB, WS_LSE = 8 * MiB;
constexpr size_t WS_W = 16 * MiB, FFN_BLK = (size_t)(2 * FF * DM + DM * FF) * 2, FFN_DOWN_OFF = (size_t)2 * FF * DM * 2;
constexpr size_t WS_FOXIN = WS_W + 8 * FFN_BLK, FOXIN_SZ = (size_t)3072 * DM * 2;
constexpr size_t WS_FOXOUT = WS_FOXIN + 2 * FOXIN_SZ, OUT_SZ = (size_t)DM * DM * 2;
constexpr size_t WS_DILIN = WS_FOXOUT + 2 * OUT_SZ, DILIN_SZ = (size_t)9216 * DM * 2;
constexpr size_t WS_DILOUT = WS_DILIN + 2 * DILIN_SZ;
constexpr size_t WS_H = WS_DILOUT + 2 * OUT_SZ;
constexpr size_t WS_BIG = WS_H + (size_t)MT * DM * 2;
constexpr size_t WS_XB = WS_BIG + (size_t)(MT / 2) * 9216 * 2;
constexpr size_t WS_END = WS_XB + (size_t)MT * DM * 2;
static_assert(WS_W + 8 * FFN_BLK == 148 * MiB && WS_H == 204 * MiB && WS_END == 620 * MiB, "workspace map");
constexpr int LDS_BYTES = 147456;

__device__ __forceinline__ unsigned f2bf(float f) { unsigned u = __builtin_bit_cast(unsigned, f); return (u + 0x7fffu + ((u >> 16) & 1u)) >> 16; }
__device__ __forceinline__ unsigned pk2(float lo, float hi) { return f2bf(lo) | (f2bf(hi) << 16); }
__device__ __forceinline__ float bflo(unsigned w) { return __builtin_bit_cast(float, w << 16); }
__device__ __forceinline__ float bfhi(unsigned w) { return __builtin_bit_cast(float, w & 0xffff0000u); }
__device__ __forceinline__ float wave_sum(float v) {
#pragma unroll
    for (int o = 1; o < 64; o <<= 1) v += __shfl_xor(v, o);
    return v;
}

__device__ __forceinline__ int fresh_tid() { int t = threadIdx.x; asm volatile("" : "+v"(t)); return t; }
struct Args { const void* in[18]; float* out; unsigned char* ws; int ph_lo, ph_hi; };

__device__ __forceinline__ int map_row(int kind, int n0) {
    if (kind == 0) return n0;
    if (kind == 1) return 256 * (n0 >> 7) + (n0 & 127);
    if (kind == 2) return 256 * (n0 >> 7) + 128 + (n0 & 127);
    return (n0 & ~255) + 128 * ((n0 >> 5) & 1) + 32 * ((n0 >> 6) & 3);
}
__device__ __forceinline__ void conv_item(const float* W, int K, int Npitch, int nblk, bf16_t* WT, int kind, LAS float* scr, int item, int lane) {
    const int kb = item / nblk, nb = item % nblk, k0 = 64 * kb, n0 = 32 * nb;
    const int drow0 = map_row(kind, n0);
#pragma unroll 8
    for (int i = 0; i < 32; ++i) { const int kk = 2 * i + (lane >> 5); scr[kk * 33 + (lane & 31)] = W[(size_t)(k0 + kk) * Npitch + n0 + (lane & 31)]; }
    asm volatile("s_waitcnt lgkmcnt(0)" ::: "memory");
    const int c = lane & 7;
#pragma unroll
    for (int j = 0; j < 4; ++j) { const int n = (lane >> 3) + 8 * j; const LAS float* s = scr + (8 * c) * 33 + n;
        u32x4 o; o.x = pk2(s[0 * 33], s[1 * 33]); o.y = pk2(s[2 * 33], s[3 * 33]); o.z = pk2(s[4 * 33], s[5 * 33]); o.w = pk2(s[6 * 33], s[7 * 33]);
        *(u32x4*)(WT + (size_t)(drow0 + n) * K + k0 + 8 * c) = o; }
    asm volatile("s_waitcnt lgkmcnt(0)" ::: "memory");
}

template <class AT> __device__ __forceinline__ void prologue_phase(AT& a, LAS unsigned char* lds) {
    const int tid = fresh_tid(), lane = tid & 63, wid = __builtin_amdgcn_readfirstlane(tid >> 6);
    const int G = gridDim.x, bid = blockIdx.x;
    unsigned char* ws = a.ws;
    {
        const float* c = (const float*)a.in[1]; const float* mod_w = (const float*)a.in[3]; const float* mod_b = (const float*)a.in[4];
        float* modbuf = (float*)(ws + WS_MOD);
        LAS float* cact = (LAS float*)lds;
        LAS float* red = (LAS float*)(lds + 32768);
        for (int e = tid; e < NB * DM; e += NTHREADS) { const int b = e >> 10, k = e & 1023; const float v = c[e]; cact[k * 8 + b] = v / (1.0f + __expf(-v)); }
        __syncthreads();
        for (int task = bid; task < 4 * 144; task += G) {
            const int i = task / 144, n0 = (task % 144) * 64, n = n0 + lane;
            float acc[8];
#pragma unroll
            for (int b = 0; b < 8; ++b) acc[b] = 0.f;
            const float* wp = mod_w + ((size_t)i * DM + 128 * wid) * MODN + n;
#pragma unroll 4
            for (int kk = 0; kk < 128; ++kk) {
                const float wv = wp[(size_t)kk * MODN];
                const f32x4 c0 = *(const LAS f32x4*)(cact + (128 * wid + kk) * 8), c1 = *(const LAS f32x4*)(cact + (128 * wid + kk) * 8 + 4);
                acc[0] += c0[0] * wv; acc[1] += c0[1] * wv; acc[2] += c0[2] * wv; acc[3] += c0[3] * wv;
                acc[4] += c1[0] * wv; acc[5] += c1[1] * wv; acc[6] += c1[2] * wv; acc[7] += c1[3] * wv;
            }
#pragma unroll
            for (int b = 0; b < 8; ++b) red[(wid * 8 + b) * 64 + lane] = acc[b];
            __syncthreads();
            {
                const int b = tid >> 6; float s = 0.f;
#pragma unroll
                for (int w = 0; w < 8; ++w) s += red[(w * 8 + b) * 64 + lane];
                s += mod_b[(size_t)i * MODN + n];
                const int sidx = n / 3072, j = (n >> 10) % 3;
                if (j == 1) s += 1.0f;
                if (j == 2 && sidx != 1) s *= 0.5f;
                modbuf[((size_t)i * NB + b) * MODN + n] = s;
            }
            __syncthreads();
        }
    }
    __syncthreads();
    {
        const int* pos = (const int*)a.in[2];
        float* cs = (float*)(ws + WS_COS); float* sn = (float*)(ws + WS_SIN);
        for (int e = bid * NTHREADS + tid; e < MT * 8; e += G * NTHREADS) {
            const int i = e & 7;
            const float invf = (i == 0) ? 1.0f : (i == 1) ? 0.1939227432012558f : (i == 2) ? 0.03760603070259094f : (i == 3) ? 0.007292664609849453f
                             : (i == 4) ? 0.0014142135623842478f : (i == 5) ? 0.00027424818836152554f : (i == 6) ? 5.3182957344688475e-05f : 1.0313385246263351e-05f;
            const float ang = (float)pos[e >> 3] * invf;
            const double rev = (double)ang * 0.15915494309189535;
            const float fr = (float)(rev - floor(rev));
            cs[e] = __builtin_amdgcn_cosf(fr); sn[e] = __builtin_amdgcn_sinf(fr);
        }
    }
    {
        LAS float* scr = (LAS float*)(lds + wid * 16384);
        const float* wg = (const float*)a.in[6]; const float* wu = (const float*)a.in[7]; const float* wd = (const float*)a.in[8];
        const float* fin = (const float*)a.in[9]; const float* fout = (const float*)a.in[13];
        const float* din = (const float*)a.in[14]; const float* dout = (const float*)a.in[17];
        const int gw = bid * NWAVES + wid, NGW = G * NWAVES;
        constexpr int I_FFN = 1408, I_FIN = 1536, I_OUT = 512, I_DIN = 4608;
        constexpr int NITEMS = 8 * 3 * I_FFN + 2 * I_FIN + 2 * I_OUT + 2 * I_DIN + 2 * I_OUT;
        for (int it = gw; it < NITEMS; it += NGW) {
            int r = it;
            if (r < 8 * 3 * I_FFN) {
                const int f = r / (3 * I_FFN); r -= f * 3 * I_FFN; const int w3 = r / I_FFN; r -= w3 * I_FFN;
                bf16_t* gu = (bf16_t*)(ws + WS_W + (size_t)f * FFN_BLK);
                if (w3 == 0) conv_item(wg + (size_t)f * DM * FF, DM, FF, FF / 32, gu, 1, scr, r, lane);
                else if (w3 == 1) conv_item(wu + (size_t)f * DM * FF, DM, FF, FF / 32, gu, 2, scr, r, lane);
                else conv_item(wd + (size_t)f * FF * DM, FF, DM, DM / 32, (bf16_t*)(ws + WS_W + (size_t)f * FFN_BLK + FFN_DOWN_OFF), 0, scr, r, lane);
                continue;
            }
            r -= 8 * 3 * I_FFN;
            if (r < 2 * I_FIN) { const int j = r / I_FIN; r -= j * I_FIN; conv_item(fin + (size_t)j * DM * 3088, DM, 3088, 96, (bf16_t*)(ws + WS_FOXIN + (size_t)j * FOXIN_SZ), 3, scr, r, lane); continue; }
            r -= 2 * I_FIN;
            if (r < 2 * I_OUT) { const int j = r / I_OUT; r -= j * I_OUT; conv_item(fout + (size_t)j * DM * DM, DM, DM, 32, (bf16_t*)(ws + WS_FOXOUT + (size_t)j * OUT_SZ), 0, scr, r, lane); continue; }
            r -= 2 * I_OUT;
            if (r < 2 * I_DIN) { const int j = r / I_DIN; r -= j * I_DIN; conv_item(din + (size_t)j * DM * 9216, DM, 9216, 288, (bf16_t*)(ws + WS_DILIN + (size_t)j * DILIN_SZ), 3, scr, r, lane); continue; }
            r -= 2 * I_DIN;
            { const int j = r / I_OUT; r -= j * I_OUT; conv_item(dout + (size_t)j * DM * DM, DM, DM, 32, (bf16_t*)(ws + WS_DILOUT + (size_t)j * OUT_SZ), 0, scr, r, lane); }
        }
    }
}

template <bool FOX>
__device__ __forceinline__ void norm_phase(LAS unsigned char* lds, const void* xin, int x_bf16, const float* g, const float* sc1p, const float* shift, bf16_t* hout,
                                           const float* wf_src, const float* bfv, float* cumloc, float* chtot) {
    const int tid = fresh_tid(), lane = tid & 63, wid = __builtin_amdgcn_readfirstlane(tid >> 6);
    const int G = gridDim.x;
    LAS float* wfL = (LAS float*)lds;
    if (FOX) {
        for (int k = tid; k < DM; k += NTHREADS) {
            const float* src = wf_src + (size_t)k * 3088;
#pragma unroll
            for (int q = 0; q < 4; ++q) { const f32x4 v = *(const f32x4*)(src + 4 * q);
#pragma unroll
                for (int e = 0; e < 4; ++e) wfL[(4 * q + e) * DM + k] = v[e]; }
        }
        __syncthreads();
    }
    for (int chunk = blockIdx.x; chunk < MT / 128; chunk += G) {
        const int b = chunk >> 5;
        const int row_base = chunk * 128 + wid * 16;
        f32x4 A[4], Bc[4];
#pragma unroll
        for (int j = 0; j < 4; ++j) {
            const int col = 4 * lane + 256 * j;
            A[j] = *(const f32x4*)(g + col) * *(const f32x4*)(sc1p + (size_t)b * MODN + col);
            Bc[j] = *(const f32x4*)(shift + (size_t)b * MODN + col);
        }
        float run = 0.f;
#pragma unroll 1
        for (int rg = 0; rg < 4; ++rg) {
            f32x4 hv[4][4];
#pragma unroll
            for (int rr = 0; rr < 4; ++rr) {
                const size_t xo = (size_t)(row_base + rg * 4 + rr) * DM + 4 * lane;
                if (x_bf16) {
#pragma unroll
                    for (int j = 0; j < 4; ++j) { const u32x2 w = *(const u32x2*)((const bf16_t*)xin + xo + 256 * j); hv[rr][j] = (f32x4){pg8::f16lo(w.x), pg8::f16hi(w.x), pg8::f16lo(w.y), pg8::f16hi(w.y)}; }
                } else {
#pragma unroll
                    for (int j = 0; j < 4; ++j) hv[rr][j] = *(const f32x4*)((const float*)xin + xo + 256 * j);
                }
            }
#pragma unroll
            for (int rr = 0; rr < 4; ++rr) {
                float ss = 0.f;
#pragma unroll
                for (int j = 0; j < 4; ++j) { const f32x4 t = hv[rr][j] * hv[rr][j]; ss += (t[0] + t[1]) + (t[2] + t[3]); }
                ss = wave_sum(ss);
                const float rstd = 1.0f / sqrtf(ss * (1.0f / DM) + 1e-6f);
                bf16_t* orow = hout + (size_t)(row_base + rg * 4 + rr) * DM + 4 * lane;
#pragma unroll
                for (int j = 0; j < 4; ++j) {
                    hv[rr][j] = hv[rr][j] * rstd * A[j] + Bc[j];
                    u32x2 w; w.x = pk2(hv[rr][j][0], hv[rr][j][1]); w.y = pk2(hv[rr][j][2], hv[rr][j][3]);
                    *(u32x2*)(orow + 256 * j) = w;
                }
            }
            if (FOX) {
                float zs[4] = {0.f, 0.f, 0.f, 0.f};
#pragma unroll 1
                for (int hh = 0; hh < 16; ++hh) {
                    f32x4 wv[4];
#pragma unroll
                    for (int j = 0; j < 4; ++j) wv[j] = *(const LAS f32x4*)(wfL + hh * DM + 4 * lane + 256 * j);
#pragma unroll
                    for (int rr = 0; rr < 4; ++rr) {
                        float s = 0.f;
#pragma unroll
                        for (int j = 0; j < 4; ++j) { const f32x4 t = hv[rr][j] * wv[j]; s += (t[0] + t[1]) + (t[2] + t[3]); }
                        s = wave_sum(s);
                        zs[rr] = ((lane & 15) == hh) ? s : zs[rr];
                    }
                }
                const float bfl = bfv[lane & 15];
                float* cp = cumloc + ((size_t)(b * NH + (lane & 15))) * SEQ + (chunk & 31) * 128 + wid * 16 + rg * 4;
#pragma unroll
                for (int rr = 0; rr < 4; ++rr) {
                    const float z = zs[rr] + bfl;
                    const float ls = -(fmaxf(-z, 0.f) + log1pf(__expf(-fabsf(z))));
                    run += ls;
                    if (lane < 16) cp[rr] = run;
                }
            }
        }
        if (FOX) { if (lane < 16) chtot[(b * NH + lane) * 256 + (chunk & 31) * 8 + wid] = run; }
    }
}

__device__ __forceinline__ void merge_phase(const bf16_t* qkv, const float* lse, bf16_t* hout) {
    const int tid = fresh_tid(), lane = tid & 63, wid = tid >> 6;
    const int gw = blockIdx.x * NWAVES + wid, NGW = gridDim.x * NWAVES;
    const int head = lane >> 2;
    for (int row = gw; row < MT / 2; row += NGW) {
        float ls[3], w[3];
#pragma unroll
        for (int g = 0; g < 3; ++g) ls[g] = lse[((size_t)row * 3 + g) * NH + head];
        const float mx = fmaxf(ls[0], fmaxf(ls[1], ls[2]));
        float sw = 0.f;
#pragma unroll
        for (int g = 0; g < 3; ++g) { w[g] = __builtin_amdgcn_exp2f(ls[g] - mx); sw += w[g]; }
        const float inv = 1.0f / sw;
        float acc[16];
#pragma unroll
        for (int e = 0; e < 16; ++e) acc[e] = 0.f;
#pragma unroll
        for (int g = 0; g < 3; ++g) {
            const u32x4* p = (const u32x4*)(qkv + (size_t)row * 9216 + g * 3072 + 16 * lane);
            const u32x4 v0 = p[0], v1 = p[1]; const float wg = w[g] * inv;
#pragma unroll
            for (int e = 0; e < 4; ++e) { acc[2 * e] += wg * bflo(v0[e]); acc[2 * e + 1] += wg * bfhi(v0[e]); acc[8 + 2 * e] += wg * bflo(v1[e]); acc[8 + 2 * e + 1] += wg * bfhi(v1[e]); }
        }
        u32x4 o0, o1;
#pragma unroll
        for (int e = 0; e < 4; ++e) { o0[e] = pk2(acc[2 * e], acc[2 * e + 1]); o1[e] = pk2(acc[8 + 2 * e], acc[8 + 2 * e + 1]); }
        u32x4* op = (u32x4*)(hout + (size_t)row * DM + 16 * lane);
        op[0] = o0; op[1] = o1;
    }
}

__device__ __forceinline__ void fox_attn_phase(int dry, LAS unsigned char* lds, bf16_t* Qb, const bf16_t* Kb, const bf16_t* Vb, const float* cumloc, const float* chtot) {
    const int tid = fresh_tid(), lane = tid & 63;
    const int G = gridDim.x;
    LAS float* dL = (LAS float*)(lds + fatt::D_OFF);
    LAS float* ctL = (LAS float*)(lds + fatt::CT_OFF);
    LAS float* pfL = (LAS float*)(lds + fatt::PFX_OFF);
    LAS float* wtL = (LAS float*)(lds + fatt::WT_OFF);
    const int vcu = (blockIdx.x & 7) * 32 + (blockIdx.x >> 3);
    for (int i = 0;; ++i) {
        int bh, qb;
        if (G == 256) { if (i >= 8) break; bh = (vcu >> 3) * 4 + (i >> 1); qb = (i & 1) ? (vcu & 7) : 15 - (vcu & 7); }
        else { const int id = i * G + blockIdx.x; if (id >= NB * NH * 16) break; const int jj = id >> 7; bh = id & 127; qb = jj ^ ((jj >> 1) & 1); }
        __syncthreads();
        {
            float v = (tid < 256) ? chtot[bh * 256 + tid] : 0.f; const float own = v;
#pragma unroll
            for (int off = 1; off < 64; off <<= 1) { const float t = __shfl_up(v, off); if (lane >= off) v += t; }
            if (lane == 63 && tid < 256) wtL[tid >> 6] = v;
            __syncthreads();
            float pre = 0.f;
            for (int w = 0; w < (tid >> 6); ++w) pre += (w < 4) ? wtL[w] : 0.f;
            if (tid < 256) pfL[tid] = v - own + pre;
        }
        __syncthreads();
        const int nk = qb * 256 + 256;
        for (int s = tid; s < nk; s += NTHREADS) {
            const int se = s | 63;
            const float a = -(cumloc[(size_t)bh * SEQ + s] + pfL[s >> 4]) * LOG2E;
            const float c = -(cumloc[(size_t)bh * SEQ + se] + pfL[se >> 4]) * LOG2E;
            dL[s] = a - c;
            if (s == se) ctL[s >> 6] = c;
        }
        if (tid == 0) ctL[nk >> 6] = 0.f;
        __syncthreads();
        fatt::attn_unit<40>(bh >> 4, bh & 15, qb, (const fatt::bf16*)Qb, (const fatt::bf16*)Kb, (const fatt::bf16*)Vb, (fatt::bf16*)Qb, (char*)(unsigned char*)lds, dry);
    }
}
__device__ __forceinline__ void dil_attn_phase(int dry, LAS unsigned char* lds, bf16_t* qkv, float* lse) {
    const int G = gridDim.x;
    for (int i = 0;; ++i) {
        const int id = i * G + blockIdx.x; if (id >= 4 * NH * 48) break;
        const int sub = id & 15, g = (id >> 4) % 3, h = (id / 48) & 15, bl = id / 768;
        int d, rho, blk;
        if (g == 0) { d = 1; rho = 0; blk = sub; } else if (g == 1) { d = 4; rho = sub >> 2; blk = sub & 3; } else { d = 16; rho = sub; blk = 0; }
        __syncthreads();
        att::Unit U;
        const size_t rowl = (size_t)bl * SEQ + rho;
        bf16_t* qp = qkv + rowl * 9216 + (size_t)g * 3072 + h * 64;
        U.Q = qp; U.K = qp + 1024; U.V = qp + 2048; U.O = qp; U.stride = (long)d * 9216;
        U.q0 = blk * 256; U.t_lo = (4 * blk - 2 > 0) ? 4 * blk - 2 : 0; U.t_hi = 4 * blk + 4; U.window = 128; U.bias = 0; U.dry = dry;
        U.lse = lse + (rowl * 3 + g) * NH + h; U.lse_stride = (long)d * 48;
        att::unit_run(lds, U);
    }
}

#define XB_TMO      128
#define XB_XCNT(j)  (256  + 64 * (j))
#define XB_XSUB(j)  (1280 + 64 * (j))
#define XB_XGEN(j)  (2304 + 64 * (j))
#define XB_TOP      3328
#define XB_TOPGEN   3392
#define XCD_BAR_WORDS 3456
#define XB_SPIN_CAP (1u << 18)

__device__ __forceinline__ unsigned xb_ld(unsigned* p)              { return __hip_atomic_load(p, __ATOMIC_RELAXED, __HIP_MEMORY_SCOPE_AGENT); }
__device__ __forceinline__ unsigned xb_add(unsigned* p, unsigned v) { return __hip_atomic_fetch_add(p, v, __ATOMIC_RELAXED, __HIP_MEMORY_SCOPE_AGENT); }
__device__ __forceinline__ unsigned xb_xcc_id() { return (unsigned)__builtin_amdgcn_s_getreg((3 << 11) | 20) & 0xFu; }
#define XB_SPIN(cond, bar) do { unsigned _sp = 0; while (cond) { __builtin_amdgcn_s_sleep(1); \
    if ((++_sp & 255u) == 0u) { if (xb_ld(&(bar)[XB_TMO])) break; if (_sp > XB_SPIN_CAP) { atomicAdd(&(bar)[XB_TMO], 1u); break; } } } } while (0)

struct XcdBarrier {
    unsigned* bar; unsigned x;
    volatile LAS unsigned* st;
};

__device__ __forceinline__ XcdBarrier xcd_barrier_post(unsigned* bar, volatile LAS unsigned* st) {
    XcdBarrier b; b.bar = bar; b.x = xb_xcc_id(); b.st = st;
    if (threadIdx.x == 0) (void)xb_add(&bar[XB_XCNT(b.x)], 1u);
    return b;
}
__device__ __forceinline__ void xcd_barrier_complete(unsigned* bar, unsigned x, unsigned& nloc, unsigned& nx) {
    const unsigned G = gridDim.x * gridDim.y * gridDim.z;
    unsigned sum, cnt, mine, sp = 0u;
    for (;;) {
        sum = 0u; cnt = 0u; mine = 0u;
#pragma unroll
        for (unsigned j = 0; j < 16; ++j) { const unsigned c = xb_ld(&bar[XB_XCNT(j)]); sum += c; cnt += (c > 0u) ? 1u : 0u; mine = (j == x) ? c : mine; }
        if (sum == G) break;
        __builtin_amdgcn_s_sleep(1);
        if ((++sp & 255u) == 0u) { if (xb_ld(&bar[XB_TMO])) break; if (sp > XB_SPIN_CAP) { atomicAdd(&bar[XB_TMO], 1u); break; } }
    }
    nloc = mine > 0u ? mine : 1u; nx = cnt > 0u ? cnt : 1u;
}

__device__ __forceinline__ void xcd_barrier(const XcdBarrier& b) {
    asm volatile("s_waitcnt vmcnt(0)" ::: "memory");
    __syncthreads();
    if (threadIdx.x == 0) {
        unsigned* bar = b.bar;
        __builtin_amdgcn_s_waitcnt(0);
        unsigned nloc = b.st[0], nx = b.st[1];
        if (nloc == 0u) { xcd_barrier_complete(bar, b.x, nloc, nx); b.st[0] = nloc; b.st[1] = nx; }
        const unsigned old = xb_add(&bar[XB_XSUB(b.x)], 1u);
        const unsigned gen = old / nloc;
        if (old + 1u == (gen + 1u) * nloc) {
            __builtin_amdgcn_fence(__ATOMIC_RELEASE, "agent");
            asm volatile("s_waitcnt vmcnt(0)" ::: "memory");
            const unsigned og = xb_add(&bar[XB_TOP], 1u);
            const unsigned tg = og / nx;
            if (og + 1u == (tg + 1u) * nx) xb_add(&bar[XB_TOPGEN], 1u);
            else XB_SPIN(xb_ld(&bar[XB_TOPGEN]) == tg, bar);
            __builtin_amdgcn_fence(__ATOMIC_ACQUIRE, "agent");
            xb_add(&bar[XB_XGEN(b.x)], 1u);
            asm volatile("s_waitcnt vmcnt(0)" ::: "memory");
        } else {
            XB_SPIN(xb_ld(&bar[XB_XGEN(b.x)]) == gen, bar);
            __builtin_amdgcn_fence(__ATOMIC_ACQUIRE, "agent");
            asm volatile("s_waitcnt vmcnt(0)" ::: "memory");
        }
    }
    __syncthreads();
}

#ifndef PMASK
#define PMASK 255
#endif
enum { OP_NORM = 0, OP_GU = 1, OP_DOWN = 2, OP_QKV = 3, OP_ATT = 4, OP_OUT = 5, OP_PROJ = 6, OP_DATT = 7, OP_MERGE = 8 };
constexpr int N_PHASES = 1 + 2 * 10 + 2 * 14;

typedef const Args __attribute__((address_space(4))) CArgs;
__device__ __forceinline__ CArgs& fresh_args() { unsigned long long p = (unsigned long long)__builtin_amdgcn_kernarg_segment_ptr(); asm volatile("" : "+s"(p)); return *(CArgs*)p; }
__device__ __forceinline__ void run_phase(LAS unsigned char* lds, int ph, int dry) {
    CArgs& a = fresh_args();
    if (ph == 0) { if (PMASK & 1) prologue_phase(a, lds); return; }
    int p = ph - 1, layer = 0, n;
    for (;;) { n = (layer & 1) ? 14 : 10; if (p < n) break; p -= n; ++layer; }
    const bool dil = (layer & 1) != 0; const int j = layer >> 1;
    int op, sub, hb = 0, ffn = 0;
    if (p < 3) { sub = 0; ffn = 0; op = p; }
    else if (p >= n - 3) { sub = 2; ffn = 1; op = p - (n - 3); }
    else { sub = 1; const int q = p - 3;
        if (!dil) op = (q == 0) ? OP_NORM : (q == 1) ? OP_QKV : (q == 2) ? OP_ATT : OP_OUT;
        else if (q == 0) op = OP_NORM; else if (q == 7) op = OP_OUT; else { hb = (q - 1) / 3; const int r = (q - 1) % 3; op = (r == 0) ? OP_PROJ : (r == 1) ? OP_DATT : OP_MERGE; } }
    unsigned char* ws = a.ws;
    const float* x0 = (const float*)a.in[0];
    float* xo = a.out;
    const bool first = (layer == 0 && sub == 0);
    bf16_t* XB = (bf16_t*)(ws + WS_XB);
    const void* xin = first ? (const void*)x0 : (const void*)XB;
    const bool last = (layer == 3 && sub == 2);
    const float* modl = (const float*)(ws + WS_MOD) + (size_t)layer * NB * MODN + (size_t)sub * 3 * DM;
    bf16_t* HB = (bf16_t*)(ws + WS_H);
    bf16_t* BIG = (bf16_t*)(ws + WS_BIG);
    const int G = gridDim.x, bid = blockIdx.x;
    const int f = layer * 2 + ffn;
    if (op == OP_NORM && (PMASK & 2)) {
        const float* g = (const float*)a.in[5] + (size_t)(layer * 3 + sub) * DM;
        if (sub == 1 && !dil)
            norm_phase<true>(lds, xin, first ? 0 : 1, g, modl + DM, modl, HB, (const float*)a.in[9] + (size_t)j * DM * 3088 + 3072, (const float*)a.in[10] + j * NH, (float*)(ws + WS_CUM), (float*)(ws + WS_CHT));
        else
            norm_phase<false>(lds, xin, first ? 0 : 1, g, modl + DM, modl, HB, nullptr, nullptr, nullptr, nullptr);
    } else if ((op == OP_GU || op == OP_DOWN || op == OP_OUT || op == OP_QKV || op == OP_PROJ) && (PMASK & 4)) {
        pg8::Gemm gm; pg8::StaticOrder S; pg8::EpiAny E;
        E.kind = 0; E.s.Hd = BIG; E.r.xin = xin; E.r.xout = last ? (void*)xo : (void*)XB; E.r.coef = modl + 2 * DM; E.r.in_bf16 = first ? 0 : 1; E.r.out_bf16 = last ? 0 : 1;
        E.q.out = BIG; E.q.fox = 1; E.q.qg = nullptr; E.q.kg = nullptr; E.q.cs = nullptr; E.q.sn = nullptr;
        if (op == OP_GU) { gm = pg8::Gemm{HB, (const bf16_t*)(ws + WS_W + (size_t)f * FFN_BLK), MT, 2 * FF, DM}; E.kind = 0; }
        else if (op == OP_DOWN) { gm = pg8::Gemm{BIG, (const bf16_t*)(ws + WS_W + (size_t)f * FFN_BLK + FFN_DOWN_OFF), MT, DM, FF}; E.kind = 1; }
        else if (op == OP_OUT) { E.kind = 1;
            if (!dil) gm = pg8::Gemm{BIG, (const bf16_t*)(ws + WS_FOXOUT + (size_t)j * OUT_SZ), MT, DM, DM};
            else gm = pg8::Gemm{HB, (const bf16_t*)(ws + WS_DILOUT + (size_t)j * OUT_SZ), MT, DM, DM}; }
        else if (op == OP_QKV) { E.kind = 2;
            gm = pg8::Gemm{HB, (const bf16_t*)(ws + WS_FOXIN + (size_t)j * FOXIN_SZ), MT, 3072, DM};
            E.q.qg = (const float*)a.in[11] + j * 64; E.q.kg = (const float*)a.in[12] + j * 64; }
        else { E.kind = 2; E.q.fox = 0;
            gm = pg8::Gemm{HB + (size_t)hb * (MT / 2) * DM, (const bf16_t*)(ws + WS_DILIN + (size_t)j * DILIN_SZ), MT / 2, 9216, DM};
            E.q.qg = (const float*)a.in[15] + j * 192; E.q.kg = (const float*)a.in[16] + j * 192;
            E.q.cs = (const float*)(ws + WS_COS) + (size_t)hb * (MT / 2) * 8; E.q.sn = (const float*)(ws + WS_SIN) + (size_t)hb * (MT / 2) * 8; }
        if (dry) E.kind = 3;
        S.init(gm.M, gm.N, G, bid);
        pg8::gemm_phase<pg8::EpiAny, pg8::StaticOrder, true, true>(lds, gm, S, E);
    } else if (op == OP_ATT && (PMASK & 32)) {
        fox_attn_phase(dry, lds, BIG, BIG + (size_t)MT * DM, BIG + (size_t)2 * MT * DM, (const float*)(ws + WS_CUM), (const float*)(ws + WS_CHT));
    } else if (op == OP_DATT && (PMASK & 64)) {
        dil_attn_phase(dry, lds, BIG, (float*)(ws + WS_LSE));
    } else if (op == OP_MERGE && (PMASK & 128)) {
        merge_phase(BIG, (const float*)(ws + WS_LSE), HB + (size_t)hb * (MT / 2) * DM);
    }
}

#ifndef REP_MASK
#define REP_MASK 0
#endif
#ifndef SYNC_REP
#define SYNC_REP 1
#endif
__device__ __forceinline__ int phase_op(int ph) {
    if (ph == 0) return 9;
    int p = ph - 1, layer = 0, n;
    for (;;) { n = (layer & 1) ? 14 : 10; if (p < n) break; p -= n; ++layer; }
    if (p < 3) return p;
    if (p >= n - 3) return p - (n - 3);
    const int q = p - 3;
    if (!(layer & 1)) return (q == 0) ? OP_NORM : (q == 1) ? OP_QKV : (q == 2) ? OP_ATT : OP_OUT;
    if (q == 0) return OP_NORM; if (q == 7) return OP_OUT;
    const int r = (q - 1) % 3; return (r == 0) ? OP_PROJ : (r == 1) ? OP_DATT : OP_MERGE;
}
#ifndef MK_COOP
#define MK_COOP 1
#endif

__global__ void __launch_bounds__(NTHREADS, 2) mk_fwd(Args a) {
    extern __shared__ __attribute__((aligned(16))) unsigned char lds_raw[];
    LAS unsigned char* lds = (LAS unsigned char*)lds_raw;
    volatile LAS unsigned* misc = (volatile LAS unsigned*)(lds + LDS_BYTES - 64);
    if (threadIdx.x < 16) misc[threadIdx.x] = 0u;
    __syncthreads();
    XcdBarrier bar = xcd_barrier_post((unsigned*)(fresh_args().ws + WS_BAR), misc);
    const int lo = fresh_args().ph_lo;
    for (int ph = lo;; ++ph) {
#if REP_MASK
        const int nrep = ((REP_MASK >> phase_op(ph)) & 1) ? 2 : 1;
        for (int rep = 0; rep < nrep; ++rep) { run_phase(lds, ph, (rep + 1 < nrep) ? 1 : 0); __syncthreads(); }
#else
        run_phase(lds, ph, 0);
#endif
        if (ph + 1 >= fresh_args().ph_hi) break;
        for (int sr = 0; sr < SYNC_REP; ++sr) { if (ph == lo) cg::this_grid().sync(); else xcd_barrier(bar); }
    }
}

extern "C" void kernel_launch(void* const* d_in, const int* in_sizes, int n_in, void* d_out, int out_size, void* d_ws, size_t ws_size, hipStream_t stream) {
    static int grid = 0;
    if (grid == 0) {
        if (n_in != 18 || out_size != MT * DM || ws_size < WS_END) { fprintf(stderr, "kernel_launch: unexpected shapes (n_in %d, out %d, ws %zu; need ws >= %zu)\n", n_in, out_size, ws_size, (size_t)WS_END); grid = -1; return; }
        int dev = 0, cus = 0, per_cu = 0;
        if (hipGetDevice(&dev) != hipSuccess || hipDeviceGetAttribute(&cus, hipDeviceAttributeMultiprocessorCount, dev) != hipSuccess) { grid = -1; return; }
        if (hipFuncSetAttribute((const void*)mk_fwd, hipFuncAttributeMaxDynamicSharedMemorySize, LDS_BYTES) != hipSuccess) { fprintf(stderr, "kernel_launch: hipFuncSetAttribute failed\n"); grid = -1; return; }
        if (hipOccupancyMaxActiveBlocksPerMultiprocessor(&per_cu, (const void*)mk_fwd, NTHREADS, LDS_BYTES) != hipSuccess || per_cu < 1) { per_cu = 1; (void)hipGetLastError(); }
        grid = cus * per_cu;
    }
    if (grid < 0) return;
    Args a{};
    for (int i = 0; i < 18; ++i) a.in[i] = d_in[i];
    a.out = (float*)d_out; a.ws = (unsigned char*)d_ws;
#if MK_COOP
    if (hipMemsetAsync((char*)d_ws + WS_BAR, 0, WS_BAR_BYTES, stream) != hipSuccess) { fprintf(stderr, "kernel_launch: memset failed\n"); return; }
    a.ph_lo = 0; a.ph_hi = N_PHASES;
    void* args[] = {&a};
    hipError_t e = hipLaunchCooperativeKernel((const void*)mk_fwd, dim3(grid), dim3(NTHREADS), args, LDS_BYTES, stream);
    if (e != hipSuccess) fprintf(stderr, "cooperative launch failed: %s (grid %d)\n", hipGetErrorString(e), grid);
#else
    for (int ph = 0; ph < N_PHASES; ++ph) {
        a.ph_lo = ph; a.ph_hi = ph + 1;
        hipLaunchKernelGGL(mk_fwd, dim3(grid), dim3(NTHREADS), LDS_BYTES, stream, a);
    }
#endif
}
```
